# Optimizing an MI355X kernel written in HIP

```python
import math
import jax, jax.numpy as jnp
from jax import lax
import numpy as np

D_MODEL = 1024
BATCH = 2
SEQ = 8192
DEPTH = 1

GLA_HEADS = 4
GLA_DK = 128
GLA_DV = 256
GLA_RANK = 16
GLA_TAU = 16.0
GLA_CHUNK = 64
GLA_K_W = GLA_HEADS * GLA_DK
GLA_V_W = GLA_HEADS * GLA_DV
DIFF_HEADS = 8
DIFF_DH = 64
DIFF_QK_W = DIFF_HEADS * 2 * DIFF_DH
DIFF_V_W = DIFF_HEADS * 2 * DIFF_DH
ROT_DIM = DIFF_DH // 4
ROPE_THETA = 500000.0
Q_BLOCK = 128
N_EXPERTS = 32
TOP_K = 4
D_FF = 1024
SWIGLU_LIMIT = 7.0
SWIGLU_ALPHA = 1.702
MOE_BLOCK = 128
DN_ALPHA = (2 * DEPTH) ** 0.25
DN_BETA = (8 * DEPTH) ** -0.25
EPS = 1e-5

IN_SPLITS = (GLA_K_W, GLA_K_W, GLA_V_W, GLA_V_W, GLA_RANK, GLA_RANK,
             DIFF_QK_W, DIFF_QK_W, DIFF_V_W, D_MODEL, D_MODEL)
VALUE_BLOCKS = (2, 8)
N_IN = sum(IN_SPLITS)

kernel_name = "hybrid_gla_diffattn_moe_deepnorm"


def _layer_norm(x, g, b):
    xf = x.astype(jnp.float32)
    mu = jnp.mean(xf, -1, keepdims=True)
    var = jnp.mean(jnp.square(xf - mu), -1, keepdims=True)
    return ((xf - mu) * lax.rsqrt(var + EPS) * g + b).astype(x.dtype)


def _rms_norm(x, g):
    xf = x.astype(jnp.float32)
    return (xf * lax.rsqrt(jnp.mean(jnp.square(xf), -1, keepdims=True) + EPS) * g).astype(x.dtype)


def _apply_partial_rope(t, cos, sin):
    half = ROT_DIM // 2
    x1 = t[..., :half].astype(jnp.float32)
    x2 = t[..., half:ROT_DIM].astype(jnp.float32)
    rot = jnp.concatenate([x1 * cos - x2 * sin, x2 * cos + x1 * sin], -1).astype(t.dtype)
    return jnp.concatenate([rot, t[..., ROT_DIM:]], -1)


def _gla_chunked(q, k, v, logf):
    B, S, H, DK = q.shape
    DV = v.shape[-1]
    N, C = S // GLA_CHUNK, GLA_CHUNK

    def blk(t):
        return t.astype(jnp.float32).reshape(B, N, C, H, t.shape[-1]).transpose(0, 3, 1, 2, 4)

    q, k, v, logf = blk(q), blk(k), blk(v), blk(logf)
    b = jnp.cumsum(logf, axis=3)
    b_last = b[:, :, :, -1:, :]
    q_in = q * jnp.exp(b)
    k_in = k * jnp.exp(-b)
    k_st = k * jnp.exp(b_last - b)
    mask = jnp.tril(jnp.ones((C, C), dtype=bool))
    att = jnp.einsum('bhncd,bhnmd->bhncm', q_in, k_in)
    att = jnp.where(mask, att, 0.0)
    o_intra = jnp.einsum('bhncm,bhnme->bhnce', att, v)
    u = jnp.einsum('bhncd,bhnce->bhnde', k_st, v)
    decay = jnp.exp(b_last[:, :, :, 0, :])

    def step(state, inp):
        dec, un = inp
        return dec[..., None] * state + un, state

    _, s_prev = lax.scan(step, jnp.zeros((B, H, DK, DV), jnp.float32),
                         (decay.transpose(2, 0, 1, 3), u.transpose(2, 0, 1, 3, 4)))
    o_inter = jnp.einsum('bhncd,nbhde->bhnce', q_in, s_prev)
    o = o_intra + o_inter
    return o.transpose(0, 2, 3, 1, 4).reshape(B, S, H, DV)


def _diff_attention(q, k, v, lam):
    B, S, H, _, DH = q.shape
    nq = S // Q_BLOCK
    scale = DH ** -0.5
    qb = q.reshape(B, nq, Q_BLOCK, H, 2, DH).transpose(1, 0, 2, 3, 4, 5)

    def one_block(qi):
        s = jnp.einsum('bqhpd,bkhpd->bhpqk', qi, k).astype(jnp.float32) * scale
        p = jax.nn.softmax(s, axis=-1)
        pw = p[:, :, 0] - lam * p[:, :, 1]
        return jnp.einsum('bhqk,bkhe->bqhe', pw.astype(v.dtype), v)

    o = lax.map(one_block, qb)
    return o.transpose(1, 0, 2, 3, 4).reshape(B, S, H, 2 * DH)


def _token_mixer(h, w_in, wf_fwd, bf_fwd, wf_bwd, bf_bwd, gla_norm_g,
                 lq1, lk1, lq2, lk2, diff_norm_g, w_br_gla, w_br_diff, w_out,
                 cos, sin, lam_init):
    B, S, D = h.shape
    proj = h @ w_in
    cuts = np.cumsum(IN_SPLITS)[:-1].tolist()
    (qg, kg, vg, rg, lr_f, lr_b, qd, kd, vd, gate_g, gate_d) = jnp.split(proj, cuts, axis=-1)

    qg = qg.reshape(B, S, GLA_HEADS, GLA_DK) * (GLA_DK ** -0.5)
    kg = kg.reshape(B, S, GLA_HEADS, GLA_DK)
    vg = vg.reshape(B, S, GLA_HEADS, GLA_DV)
    logf_f = (jax.nn.log_sigmoid((lr_f @ wf_fwd + bf_fwd).astype(jnp.float32)) / GLA_TAU
              ).reshape(B, S, GLA_HEADS, GLA_DK)
    logf_b = (jax.nn.log_sigmoid((lr_b @ wf_bwd + bf_bwd).astype(jnp.float32)) / GLA_TAU
              ).reshape(B, S, GLA_HEADS, GLA_DK)
    o_f = _gla_chunked(qg, kg, vg, logf_f)
    flip = lambda t: jnp.flip(t, axis=1)
    o_b = flip(_gla_chunked(flip(qg), flip(kg), flip(vg), flip(logf_b)))
    o_gla = _rms_norm(o_f + o_b, gla_norm_g).astype(h.dtype).reshape(B, S, GLA_V_W)
    o_gla = o_gla * jax.nn.silu(rg)

    qd = _apply_partial_rope(qd.reshape(B, S, DIFF_HEADS, 2, DIFF_DH), cos, sin)
    kd = _apply_partial_rope(kd.reshape(B, S, DIFF_HEADS, 2, DIFF_DH), cos, sin)
    vd = vd.reshape(B, S, DIFF_HEADS, 2 * DIFF_DH)
    lam = (jnp.exp(jnp.sum(lq1.astype(jnp.float32) * lk1.astype(jnp.float32)))
           - jnp.exp(jnp.sum(lq2.astype(jnp.float32) * lk2.astype(jnp.float32))) + lam_init)
    o_diff = _diff_attention(qd, kd, vd, lam)
    o_diff = (_rms_norm(o_diff, diff_norm_g) * (1.0 - lam_init)).reshape(B, S, DIFF_V_W)

    mixed = (jax.nn.sigmoid(gate_g) * (o_gla @ w_br_gla)
             + jax.nn.sigmoid(gate_d) * (o_diff @ w_br_diff))
    return mixed @ w_out


def _moe(h, router_w, router_b, w_gate, b_gate, w_up, b_up, w_down, b_down):
    B, S, D = h.shape
    T = B * S
    A = T * TOP_K
    xf = h.reshape(T, D)
    logits = (xf @ router_w + router_b).astype(jnp.float32)
    top_v, top_i = lax.top_k(logits, TOP_K)
    gates = jax.nn.softmax(top_v, axis=-1)

    e_flat = top_i.reshape(A).astype(jnp.int32)
    tok = jnp.arange(A, dtype=jnp.int32) // TOP_K
    w_flat = gates.reshape(A)
    order = jnp.argsort(e_flat)
    e_sorted = e_flat[order]
    counts = jnp.bincount(e_flat, length=N_EXPERTS)
    padded = ((counts + MOE_BLOCK - 1) // MOE_BLOCK) * MOE_BLOCK
    pend = jnp.cumsum(padded)
    pstart = pend - padded
    ustart = jnp.cumsum(counts) - counts
    dest = pstart[e_sorted] + jnp.arange(A, dtype=jnp.int32) - ustart[e_sorted]
    P = A + N_EXPERTS * MOE_BLOCK
    NB = P // MOE_BLOCK
    row_tok = jnp.full((P,), T, jnp.int32).at[dest].set(tok[order])
    row_w = jnp.zeros((P,), xf.dtype).at[dest].set(w_flat[order].astype(xf.dtype))
    blk_e = jnp.minimum(jnp.searchsorted(pend, jnp.arange(NB, dtype=jnp.int32) * MOE_BLOCK,
                                         side='right'), N_EXPERTS - 1).astype(jnp.int32)
    x_pad = jnp.concatenate([xf, jnp.zeros((1, D), xf.dtype)], axis=0)
    xb = x_pad[row_tok].reshape(NB, MOE_BLOCK, D)

    def expert_block(args):
        xe, e = args
        g = jnp.minimum(xe @ w_gate[e] + b_gate[e], SWIGLU_LIMIT)
        u = jnp.clip(xe @ w_up[e] + b_up[e], -SWIGLU_LIMIT, SWIGLU_LIMIT)
        a = g * jax.nn.sigmoid(SWIGLU_ALPHA * g) * (u + 1.0)
        return a @ w_down[e] + b_down[e]

    yb = lax.map(expert_block, (xb, blk_e)).reshape(P, D)
    y = jnp.zeros((T + 1, D), yb.dtype).at[row_tok].add(yb * row_w[:, None])[:T]
    return y.reshape(B, S, D)


def setup_inputs(seed: int = 0) -> dict:
    key = jax.random.key(seed)
    ks = iter(jax.random.split(key, 32))
    L = DEPTH

    def nrm(shape, scale):
        return jax.random.normal(next(ks), shape, jnp.float32) * scale

    col_scale = np.concatenate([np.full((n,), DN_BETA if i in VALUE_BLOCKS else 1.0, np.float32)
                                for i, n in enumerate(IN_SPLITS)])
    return {
        "x": nrm((BATCH, SEQ, D_MODEL), 1.0),
        "ln0_g": 1.0 + nrm((D_MODEL,), 0.02),
        "ln0_b": nrm((D_MODEL,), 0.02),
        "w_in": nrm((L, D_MODEL, N_IN), D_MODEL ** -0.5) * jnp.asarray(col_scale),
        "gla_wf_fwd": nrm((L, GLA_RANK, GLA_K_W), GLA_RANK ** -0.5),
        "gla_bf_fwd": nrm((L, GLA_K_W), 0.1),
        "gla_wf_bwd": nrm((L, GLA_RANK, GLA_K_W), GLA_RANK ** -0.5),
        "gla_bf_bwd": nrm((L, GLA_K_W), 0.1),
        "gla_norm_g": 1.0 + nrm((L, GLA_DV), 0.02),
        "diff_lq1": nrm((L, DIFF_DH), 0.1),
        "diff_lk1": nrm((L, DIFF_DH), 0.1),
        "diff_lq2": nrm((L, DIFF_DH), 0.1),
        "diff_lk2": nrm((L, DIFF_DH), 0.1),
        "diff_norm_g": 1.0 + nrm((L, 2 * DIFF_DH), 0.02),
        "w_br_gla": nrm((L, GLA_V_W, D_MODEL), GLA_V_W ** -0.5 * DN_BETA),
        "w_br_diff": nrm((L, DIFF_V_W, D_MODEL), DIFF_V_W ** -0.5 * DN_BETA),
        "w_out": nrm((L, D_MODEL, D_MODEL), D_MODEL ** -0.5 * DN_BETA),
        "ln1_g": 1.0 + nrm((L, D_MODEL), 0.02),
        "ln1_b": nrm((L, D_MODEL), 0.02),
        "router_w": nrm((L, D_MODEL, N_EXPERTS), D_MODEL ** -0.5),
        "router_b": nrm((L, N_EXPERTS), 0.01),
        "exp_w_gate": nrm((L, N_EXPERTS, D_MODEL, D_FF), D_MODEL ** -0.5),
        "exp_b_gate": nrm((L, N_EXPERTS, D_FF), 0.02),
        "exp_w_up": nrm((L, N_EXPERTS, D_MODEL, D_FF), D_MODEL ** -0.5),
        "exp_b_up": nrm((L, N_EXPERTS, D_FF), 0.02),
        "exp_w_down": nrm((L, N_EXPERTS, D_FF, D_MODEL), D_FF ** -0.5 * DN_BETA),
        "exp_b_down": nrm((L, N_EXPERTS, D_MODEL), 0.02),
        "ln2_g": 1.0 + nrm((L, D_MODEL), 0.02),
        "ln2_b": nrm((L, D_MODEL), 0.02),
    }


def reference(x, ln0_g, ln0_b, w_in, gla_wf_fwd, gla_bf_fwd, gla_wf_bwd, gla_bf_bwd,
              gla_norm_g, diff_lq1, diff_lk1, diff_lq2, diff_lk2, diff_norm_g,
              w_br_gla, w_br_diff, w_out, ln1_g, ln1_b, router_w, router_b,
              exp_w_gate, exp_b_gate, exp_w_up, exp_b_up, exp_w_down, exp_b_down,
              ln2_g, ln2_b):
    S = x.shape[1]
    pos = jnp.arange(S, dtype=jnp.float32)
    inv_freq = jnp.power(ROPE_THETA, -jnp.arange(0, ROT_DIM, 2, dtype=jnp.float32) / ROT_DIM)
    ang = pos[:, None] * inv_freq[None, :]
    cos = jnp.cos(ang)[None, :, None, None, :]
    sin = jnp.sin(ang)[None, :, None, None, :]

    h = _layer_norm(x, ln0_g, ln0_b)
    for l in range(DEPTH):
        lam_init = 0.8 - 0.6 * math.exp(-0.3 * l)
        mix = _token_mixer(h, w_in[l], gla_wf_fwd[l], gla_bf_fwd[l], gla_wf_bwd[l], gla_bf_bwd[l],
                           gla_norm_g[l], diff_lq1[l], diff_lk1[l], diff_lq2[l], diff_lk2[l],
                           diff_norm_g[l], w_br_gla[l], w_br_diff[l], w_out[l],
                           cos, sin, lam_init)
        h = _layer_norm(DN_ALPHA * h + mix, ln1_g[l], ln1_b[l])
        ffn = _moe(h, router_w[l], router_b[l], exp_w_gate[l], exp_b_gate[l],
                   exp_w_up[l], exp_b_up[l], exp_w_down[l], exp_b_down[l])
        h = _layer_norm(DN_ALPHA * h + ffn, ln2_g[l], ln2_b[l])
    return h
```

```cpp
#include <hip/hip_runtime.h>
#include <cstdio>
#include <cstdint>

#define GAS __attribute__((address_space(1)))
#define LAS __attribute__((address_space(3)))
typedef unsigned short bf16_t;
typedef short bf16x8 __attribute__((ext_vector_type(8)));
typedef short s16x4 __attribute__((ext_vector_type(4)));
typedef float f32x2 __attribute__((ext_vector_type(2)));
typedef float f32x4 __attribute__((ext_vector_type(4)));
typedef float f32x8 __attribute__((ext_vector_type(8)));
typedef float f32x16 __attribute__((ext_vector_type(16)));
typedef unsigned u32x2 __attribute__((ext_vector_type(2)));
typedef unsigned u32x4 __attribute__((ext_vector_type(4)));

constexpr int M = 16384, D = 1024, SEQ = 8192, NE = 32, TOPK = 4, DFF = 1024;
constexpr float DN_ALPHA = 1.189207115002721f;
constexpr float LN_EPS = 1e-5f;
constexpr float LAM_INIT = 0.2f;
constexpr int NIN = 8224;

typedef __bf16 bf16x2_t __attribute__((ext_vector_type(2)));
__device__ __forceinline__ unsigned cvt_pk_bf16(float lo, float hi) { f32x2 v = {lo, hi}; bf16x2_t b = __builtin_convertvector(v, bf16x2_t); return __builtin_bit_cast(unsigned, b); }
__device__ __forceinline__ float bf2f(unsigned short b) { return __uint_as_float(((unsigned)b) << 16); }
__device__ __forceinline__ float bflo(unsigned w) { return __uint_as_float(w << 16); }
__device__ __forceinline__ float bfhi(unsigned w) { return __uint_as_float(w & 0xffff0000u); }
__device__ __forceinline__ float fast_exp(float x) { return __builtin_amdgcn_exp2f(x * 1.4426950408889634f); }
__device__ __forceinline__ float fast_sigmoid(float x) { return __builtin_amdgcn_rcpf(1.0f + fast_exp(-x)); }

namespace pg8 {
constexpr int BM = 256, BK = 64, HALF = 128, HTB = HALF * BK * 2, STAGE_BYTES = 8 * HTB, NXCD = 8, WGM = 8;
__host__ __device__ __forceinline__ int lds_byte(int r, int c) { const int st = (r >> 4) * 2 + (c >> 5), rr = r & 15, cc = c & 31, ob = rr * 64 + cc * 2; return st * 1024 + (ob ^ (((ob >> 9) & 1) << 5)); }
__host__ __device__ __forceinline__ void stage_rc(int b, int& R, int& C) { const int st = b / 1024, sb = b % 1024, swz = sb ^ (((sb >> 9) & 1) << 5); R = (st >> 1) * 16 + swz / 64; C = (st & 1) * 32 + (swz % 64) / 2; }
__host__ __device__ __forceinline__ int perm32(int rho) { const int n = rho >> 4, i = rho & 15; return 8 * (i >> 2) + 4 * n + (i & 3); }

struct Unit { int pm, pn, bt, e; const bf16_t* A; const bf16_t* Bt; };
struct Gemm { const bf16_t* A; const bf16_t* Bt; int M, N, K; };

struct StaticOrder {
    static constexpr bool GATHER = false; __device__ __forceinline__ unsigned row_off(const Unit&, int) const { return 0u; }
    int nM, nN, nwg, G, c;
    __device__ __forceinline__ void init(int M_, int N_, int G_, int c_) { nM = M_ / BM; nN = N_ / BM; nwg = nM * nN; G = G_; c = c_; }
    __device__ __forceinline__ bool next(int i, Unit& u) const {
        const long L = (long)i * G + c; if (L >= nwg) return false;
        int wgid = (int)L; { const int q = nwg / NXCD, r = nwg % NXCD, xcd = wgid % NXCD, off = wgid / NXCD; wgid = (xcd < r ? xcd * (q + 1) : r * (q + 1) + (xcd - r) * q) + off; }
        const int nig = WGM * nN, gid = wgid / nig, fm = gid * WGM, gsz = (nM - fm) < WGM ? (nM - fm) : WGM;
        u.pm = fm + ((wgid % nig) % gsz); u.pn = (wgid % nig) / gsz; u.bt = u.pn; u.e = 0; u.A = nullptr; u.Bt = nullptr; return true;
    }
    __device__ __forceinline__ void a_ready(const Unit&) const {}
    __device__ __forceinline__ void done(const Unit&) const {}
};
struct InProjOrder {
    static constexpr bool GATHER = false; __device__ __forceinline__ unsigned row_off(const Unit&, int) const { return 0u; }
    StaticOrder S0; int c; bool fast;
    __device__ __forceinline__ bool next(int i, Unit& u) const {
        if (!fast) return S0.next(i, u);
        if (i >= 6) return false;
        u.pm = 8 * (c >> 5) + (c & 7); u.pn = ((c >> 3) & 3) + 4 * i; u.bt = u.pn; u.e = 0; u.A = nullptr; u.Bt = nullptr; return true;
    }
    __device__ __forceinline__ void a_ready(const Unit&) const {}
    __device__ __forceinline__ void done(const Unit&) const {}
};
struct MoeOrder {
    static constexpr bool GATHER = false; __device__ __forceinline__ unsigned row_off(const Unit&, int) const { return 0u; }
    int ntiles, nN, G, c; const LAS int* tile_e; long first;
    __device__ __forceinline__ bool next(int i, Unit& u) const {
        const long L = first + (long)i * G + c; if (L >= (long)ntiles * nN) return false;
        u.pm = (int)(L / nN); u.pn = (int)(L % nN); u.e = tile_e[u.pm]; u.bt = u.e * nN + u.pn; u.A = nullptr; u.Bt = nullptr; return true;
    }
    __device__ __forceinline__ void a_ready(const Unit&) const {}
    __device__ __forceinline__ void done(const Unit&) const {}
};

constexpr int H1B_SPLIT = 13824; constexpr unsigned H1B_LO = 293u << 20, H1B_HI = 144u << 20;
__device__ __forceinline__ unsigned h1b_off(int row) { return row < H1B_SPLIT ? H1B_LO + (unsigned)row * 2048u : H1B_HI + (unsigned)(row - H1B_SPLIT) * 2048u; }
struct MoeGatherOrder {
    static constexpr bool GATHER = true;
    int ntiles, nN, G, c; const LAS int* tile_e; const int* src; long lim;
    __device__ __forceinline__ bool next(int i, Unit& u) const {
        const long L = (long)i * G + c; if (L >= lim) return false;
        u.pm = (int)(L / nN); u.pn = (int)(L % nN); u.e = tile_e[u.pm]; u.bt = u.e * nN + u.pn; u.A = nullptr; u.Bt = nullptr; return true;
    }
    __device__ __forceinline__ unsigned row_off(const Unit& u, int r) const { return h1b_off(src[u.pm * BM + r]); }
    __device__ __forceinline__ void a_ready(const Unit&) const {}
    __device__ __forceinline__ void done(const Unit&) const {}
};

struct MoeMixOrder {
    static constexpr bool GATHER = true;
    int c, l12, f13; long base12; const LAS int* tile_e; const int* src; unsigned act_off; const unsigned char* ws; long b_wgu, b_wd;
    __device__ __forceinline__ bool next(int i, Unit& u) const {
        if (i > 0 || c >= l12 + f13) return false;
        const int st = c >= l12 ? 1 : 0; const long x = st ? (long)(c - l12) : base12 + c; const int sh = 3 - st;
        u.pm = (int)(x >> sh); u.pn = (int)(x & ((1 << sh) - 1)); const int e = tile_e[u.pm]; u.e = e | (st << 8); u.bt = (e << sh) + u.pn;
        u.A = (const bf16_t*)ws; u.Bt = (const bf16_t*)(ws + b_wgu + (long)st * (b_wd - b_wgu)); return true;
    }
    __device__ __forceinline__ unsigned row_off(const Unit& u, int rr) const { const int row = u.pm * BM + rr; return (u.e & 256) ? act_off + (unsigned)row * 2048u : h1b_off(src[row]); }
    __device__ __forceinline__ void a_ready(const Unit&) const {}
    __device__ __forceinline__ void done(const Unit&) const {}
};

#define PG8_FOR_AI_M _Pragma("unroll") for (int ai = 0; ai < 2; ++ai) _Pragma("unroll") for (int m = 0; m < 4; ++m)
__device__ __forceinline__ u32x4 pack8(const f32x4 v0, const f32x4 v1) { u32x4 w; w.x = cvt_pk_bf16(v0[0], v0[1]); w.y = cvt_pk_bf16(v0[2], v0[3]); w.z = cvt_pk_bf16(v1[0], v1[1]); w.w = cvt_pk_bf16(v1[2], v1[3]); return w; }

__device__ __forceinline__ int vt_col(int t) { return (t & ~12) | ((t & 4) << 1) | ((t & 8) >> 1); }
struct EpiIn {
    static constexpr bool PERM = true, AFTER_DRAIN = false;
    bf16_t *qkg, *vg, *rg, *qd, *kd, *vd; const float* rope;
    __device__ __forceinline__ void operator()(const f32x4 (&acc)[2][2][4][2], const Unit& u, int wr, int wc, int fr, int fq) const {
        const int grp = u.pn >> 2, ct = u.pn & 3;
        bf16_t* base = grp == 0 ? qkg : grp == 1 ? vg : grp == 2 ? rg : grp == 3 ? qd : grp == 4 ? kd : vd;
        const int row0 = u.pm * BM + wr * 64 + fr, col0 = ct * BM + wc * 32 + 8 * fq;
        const float sc = (grp == 0 && ct < 2) ? 0.08838834764831845f : (grp == 3 ? 0.18033688011112042f : 1.0f);
        const bool rot = (grp == 3 || grp == 4) && ((wc & 1) == 0);
        PG8_FOR_AI_M {
            const int row = row0 + ai * HALF + m * 16;
            f32x4 cs0, cs1, sn0, sn1;
            if (rot) { const float* rp = rope + (size_t)(row & (SEQ - 1)) * 8; cs0 = *(const f32x4*)rp; cs1 = *(const f32x4*)(rp + 4); sn0 = *(const f32x4*)(rp + SEQ * 8); sn1 = *(const f32x4*)(rp + SEQ * 8 + 4); }
#pragma unroll
            for (int bj = 0; bj < 2; ++bj) {
                f32x4 v0 = acc[ai][bj][m][0], v1 = acc[ai][bj][m][1];
                if (rot && fq < 2) {
                    const f32x4 cs = fq ? cs1 : cs0, sn = fq ? sn1 : sn0;
                    const f32x4 a0 = v0 * cs - v1 * sn, a1 = v1 * cs + v0 * sn; v0 = a0; v1 = a1;
                }
                if (grp == 2) {
#pragma unroll
                    for (int j = 0; j < 4; ++j) { v0[j] = v0[j] * fast_sigmoid(v0[j]); v1[j] = v1[j] * fast_sigmoid(v1[j]); }
                }
                v0 = v0 * sc; v1 = v1 * sc;
                if (grp == 5) {
                    const int c0 = col0 + bj * HALF; bf16_t* vtp = base + ((size_t)((row >> 13) * 8 + (c0 >> 7)) * 128 + (c0 & 127)) * SEQ + vt_col(row & (SEQ - 1));
                    const u32x4 w = pack8(v0, v1);
                    vtp[0] = (bf16_t)(w.x & 0xffffu); vtp[SEQ] = (bf16_t)(w.x >> 16); vtp[2 * SEQ] = (bf16_t)(w.y & 0xffffu); vtp[3 * SEQ] = (bf16_t)(w.y >> 16);
                    vtp[4 * SEQ] = (bf16_t)(w.z & 0xffffu); vtp[5 * SEQ] = (bf16_t)(w.z >> 16); vtp[6 * SEQ] = (bf16_t)(w.w & 0xffffu); vtp[7 * SEQ] = (bf16_t)(w.w >> 16);
                } else
                *(u32x4*)(base + (size_t)row * D + col0 + bj * HALF) = pack8(v0, v1);
            }
        }
    }
};
struct EpiSig {
    static constexpr bool PERM = true, AFTER_DRAIN = false;
    bf16_t *sgg, *sgd;
    __device__ __forceinline__ void operator()(const f32x4 (&acc)[2][2][4][2], const Unit& u, int wr, int wc, int fr, int fq) const {
        bf16_t* base = (u.pn < 4) ? sgg : sgd; const int ct = u.pn & 3;
        const int row0 = u.pm * BM + wr * 64 + fr, col0 = ct * BM + wc * 32 + 8 * fq;
        PG8_FOR_AI_M {
            const int row = row0 + ai * HALF + m * 16;
#pragma unroll
            for (int bj = 0; bj < 2; ++bj) {
                f32x4 v0 = acc[ai][bj][m][0], v1 = acc[ai][bj][m][1];
#pragma unroll
                for (int j = 0; j < 4; ++j) { v0[j] = fast_sigmoid(v0[j]); v1[j] = fast_sigmoid(v1[j]); }
                *(u32x4*)(base + (size_t)row * D + col0 + bj * HALF) = pack8(v0, v1);
            }
        }
    }
};
struct EpiMulF32 {
    static constexpr bool PERM = false, AFTER_DRAIN = false;
    const bf16_t* gate; float* out;
    __device__ __forceinline__ void operator()(const f32x4 (&acc)[2][2][4][2], const Unit& u, int wr, int wc, int fr, int fq) const {
        const int row0 = u.pm * BM + wr * 64 + fr, col0 = u.pn * BM + wc * 32 + 4 * fq;
        PG8_FOR_AI_M {
            const size_t off = (size_t)(row0 + ai * HALF + m * 16) * D + col0;
#pragma unroll
            for (int bj = 0; bj < 2; ++bj)
#pragma unroll
                for (int n = 0; n < 2; ++n) {
                    const u32x2 g = *(const u32x2*)(gate + off + bj * HALF + n * 16);
                    const f32x4 a = acc[ai][bj][m][n];
                    f32x4 o; o[0] = bflo(g.x) * a[0]; o[1] = bfhi(g.x) * a[1]; o[2] = bflo(g.y) * a[2]; o[3] = bfhi(g.y) * a[3];
                    *(f32x4*)(out + off + bj * HALF + n * 16) = o;
                }
        }
    }
};
struct EpiAddMulBf16 {
    static constexpr bool PERM = true, AFTER_DRAIN = false;
    const bf16_t* gate; const float* part; bf16_t* out;
    __device__ __forceinline__ void operator()(const f32x4 (&acc)[2][2][4][2], const Unit& u, int wr, int wc, int fr, int fq) const {
        const int row0 = u.pm * BM + wr * 64 + fr, col0 = u.pn * BM + wc * 32 + 8 * fq;
        PG8_FOR_AI_M {
            const size_t off = (size_t)(row0 + ai * HALF + m * 16) * D + col0;
#pragma unroll
            for (int bj = 0; bj < 2; ++bj) {
                const u32x4 g = *(const u32x4*)(gate + off + bj * HALF);
                const f32x4 p0 = *(const f32x4*)(part + off + bj * HALF), p1 = *(const f32x4*)(part + off + bj * HALF + 4);
                const f32x4 a0 = acc[ai][bj][m][0], a1 = acc[ai][bj][m][1];
                f32x4 v0, v1;
                v0[0] = p0[0] + bflo(g.x) * a0[0]; v0[1] = p0[1] + bfhi(g.x) * a0[1]; v0[2] = p0[2] + bflo(g.y) * a0[2]; v0[3] = p0[3] + bfhi(g.y) * a0[3];
                v1[0] = p1[0] + bflo(g.z) * a1[0]; v1[1] = p1[1] + bfhi(g.z) * a1[1]; v1[2] = p1[2] + bflo(g.w) * a1[2]; v1[3] = p1[3] + bfhi(g.w) * a1[3];
                *(u32x4*)(out + off + bj * HALF) = pack8(v0, v1);
            }
        }
    }
};
struct EpiResid {
    static constexpr bool PERM = false, AFTER_DRAIN = false;
    const bf16_t* res; float* out;
    __device__ __forceinline__ void operator()(const f32x4 (&acc)[2][2][4][2], const Unit& u, int wr, int wc, int fr, int fq) const {
        const int row0 = u.pm * BM + wr * 64 + fr, col0 = u.pn * BM + wc * 32 + 4 * fq;
        PG8_FOR_AI_M {
            const size_t off = (size_t)(row0 + ai * HALF + m * 16) * D + col0;
#pragma unroll
            for (int bj = 0; bj < 2; ++bj)
#pragma unroll
                for (int n = 0; n < 2; ++n) {
                    const u32x2 g = *(const u32x2*)(res + off + bj * HALF + n * 16);
                    const f32x4 a = acc[ai][bj][m][n];
                    f32x4 o; o[0] = DN_ALPHA * bflo(g.x) + a[0]; o[1] = DN_ALPHA * bfhi(g.x) + a[1]; o[2] = DN_ALPHA * bflo(g.y) + a[2]; o[3] = DN_ALPHA * bfhi(g.y) + a[3];
                    *(f32x4*)(out + off + bj * HALF + n * 16) = o;
                }
        }
    }
};
struct ChainOrder {
    static constexpr bool GATHER = false; __device__ __forceinline__ unsigned row_off(const Unit&, int) const { return 0u; }
    StaticOrder S0; const unsigned char* ws; long a_h0, a_of, a_o1, b_gate, b_bra, b_brb;
    __device__ __forceinline__ bool next(int i, Unit& u) const {
        if (!S0.next(i >> 2, u)) return false;
        const long st = i & 3, odd = st & 1, hi = st >> 1; u.e = (int)st; u.bt = u.pn;
        const long offA = a_h0 + odd * ((a_of - a_h0) + hi * (a_o1 - a_of));
        const long offB = odd * (b_bra + hi * (b_brb - b_bra)) + (1 - odd) * (b_gate + hi * (1024L * 1024L * 2L));
        u.A = (const bf16_t*)(ws + offA); u.Bt = (const bf16_t*)(ws + offB); return true;
    }
    __device__ __forceinline__ void a_ready(const Unit&) const {}
    __device__ __forceinline__ void done(const Unit&) const {}
};
struct EpiChain {
    static constexpr bool PERM = true, AFTER_DRAIN = false;
    bf16_t* sgg; bf16_t* sgd; float* part; bf16_t* mixed;
    __device__ __forceinline__ void operator()(const f32x4 (&acc)[2][2][4][2], const Unit& u, int wr, int wc, int fr, int fq) const {
        const int row0 = u.pm * BM + wr * 64 + fr, col0 = u.pn * BM + wc * 32 + 8 * fq;
        if (u.e == 0 || u.e == 2) {
            bf16_t* base = u.e == 0 ? sgg : sgd;
            PG8_FOR_AI_M {
                const size_t off = (size_t)(row0 + ai * HALF + m * 16) * D + col0;
#pragma unroll
                for (int bj = 0; bj < 2; ++bj) {
                    f32x4 v0 = acc[ai][bj][m][0], v1 = acc[ai][bj][m][1];
#pragma unroll
                    for (int j = 0; j < 4; ++j) { v0[j] = fast_sigmoid(v0[j]); v1[j] = fast_sigmoid(v1[j]); }
                    *(u32x4*)(base + off + bj * HALF) = pack8(v0, v1);
                }
            }
        } else {
            const bf16_t* gate = u.e == 1 ? sgg : sgd;
            PG8_FOR_AI_M {
                const size_t off = (size_t)(row0 + ai * HALF + m * 16) * D + col0;
#pragma unroll
                for (int bj = 0; bj < 2; ++bj) {
                    const u32x4 g = *(const u32x4*)(gate + off + bj * HALF);
                    const f32x4 a0 = acc[ai][bj][m][0], a1 = acc[ai][bj][m][1];
                    f32x4 v0, v1;
                    v0[0] = bflo(g.x) * a0[0]; v0[1] = bfhi(g.x) * a0[1]; v0[2] = bflo(g.y) * a0[2]; v0[3] = bfhi(g.y) * a0[3];
                    v1[0] = bflo(g.z) * a1[0]; v1[1] = bfhi(g.z) * a1[1]; v1[2] = bflo(g.w) * a1[2]; v1[3] = bfhi(g.w) * a1[3];
                    if (u.e == 1) { *(f32x4*)(part + off + bj * HALF) = v0; *(f32x4*)(part + off + bj * HALF + 4) = v1; }
                    else { const f32x4 p0 = *(const f32x4*)(part + off + bj * HALF), p1 = *(const f32x4*)(part + off + bj * HALF + 4);
                        *(u32x4*)(mixed + off + bj * HALF) = pack8(p0 + v0, p1 + v1); }
                }
                asm volatile("" ::: "memory");
            }
        }
    }
};
struct EpiSwiglu {
    static constexpr bool PERM = true, AFTER_DRAIN = false;
    const float* bgate; const float* bup; bf16_t* out;
    __device__ __forceinline__ void operator()(const f32x4 (&acc)[2][2][4][2], const Unit& u, int wr, int wc, int fr, int fq) const {
        const int row0 = u.pm * BM + wr * 64 + fr, col0 = u.pn * HALF + wc * 32 + 8 * fq;
        const float* bg = bgate + (size_t)u.e * DFF + col0; const float* bu = bup + (size_t)u.e * DFF + col0;
        const f32x4 bg0 = *(const f32x4*)bg, bg1 = *(const f32x4*)(bg + 4), bu0 = *(const f32x4*)bu, bu1 = *(const f32x4*)(bu + 4);
        PG8_FOR_AI_M {
            const size_t off = (size_t)(row0 + ai * HALF + m * 16) * DFF + col0;
            f32x4 r0, r1;
#pragma unroll
            for (int j = 0; j < 4; ++j) {
                float g = fminf(acc[ai][0][m][0][j] + bg0[j], 7.0f), up = fminf(fmaxf(acc[ai][1][m][0][j] + bu0[j], -7.0f), 7.0f);
                r0[j] = g * fast_sigmoid(1.702f * g) * (up + 1.0f);
                g = fminf(acc[ai][0][m][1][j] + bg1[j], 7.0f); up = fminf(fmaxf(acc[ai][1][m][1][j] + bu1[j], -7.0f), 7.0f);
                r1[j] = g * fast_sigmoid(1.702f * g) * (up + 1.0f);
            }
            *(u32x4*)(out + off) = pack8(r0, r1);
        }
    }
};
struct EpiBiasBf16 {
    static constexpr bool PERM = true, AFTER_DRAIN = false;
    const float* bias; bf16_t* out;
    __device__ __forceinline__ void operator()(const f32x4 (&acc)[2][2][4][2], const Unit& u, int wr, int wc, int fr, int fq) const {
        const int row0 = u.pm * BM + wr * 64 + fr, col0 = u.pn * BM + wc * 32 + 8 * fq;
        const float* bp = bias + (size_t)u.e * D + col0;
        f32x4 bv[2][2];
#pragma unroll
        for (int bj = 0; bj < 2; ++bj) { bv[bj][0] = *(const f32x4*)(bp + bj * HALF); bv[bj][1] = *(const f32x4*)(bp + bj * HALF + 4); }
        PG8_FOR_AI_M {
            const size_t off = (size_t)(row0 + ai * HALF + m * 16) * D + col0;
#pragma unroll
            for (int bj = 0; bj < 2; ++bj) *(u32x4*)(out + off + bj * HALF) = pack8(acc[ai][bj][m][0] + bv[bj][0], acc[ai][bj][m][1] + bv[bj][1]);
        }
    }
};
struct EpiMoe {
    static constexpr bool PERM = true, AFTER_DRAIN = false;
    EpiSwiglu a; EpiBiasBf16 b;
    __device__ __forceinline__ void operator()(const f32x4 (&acc)[2][2][4][2], const Unit& u, int wr, int wc, int fr, int fq) const {
        if (u.e & 256) { Unit v = u; v.e = u.e & 255; b(acc, v, wr, wc, fr, fq); } else a(acc, u, wr, wc, fr, fq);
    }
};

template <class Epi, class Sched, bool ALIGN_EPI = false, bool SP2 = false>
__device__ __forceinline__ void gemm_phase(LAS unsigned char* lds, const Gemm g, const Sched& S, const Epi& E) {
    const int tid = threadIdx.x, wid = __builtin_amdgcn_readfirstlane(tid >> 6), lane = tid & 63, wr = wid >> 2, wc = wid & 3, fr = lane & 15, fq = lane >> 4;
    const int K = g.K, nt = K / BK;
    unsigned voffA[2], voffB[2];
#pragma unroll
    for (int i = 0; i < 2; ++i) { int R, C; stage_rc(tid * 16 + i * 8192, R, C); const int Rb = Epi::PERM ? ((R & ~31) + perm32(R & 31)) : R;
        voffA[i] = (unsigned)(R * K + C) * 2u; voffB[i] = (unsigned)(Rb * K + C) * 2u; }
    unsigned vgc[2][2] = {{0u, 0u}, {0u, 0u}}, vgn[2][2] = {{0u, 0u}, {0u, 0u}}, vgnn[2][2] = {{0u, 0u}, {0u, 0u}}; int gR[2], gC[2];
#pragma unroll
    for (int i = 0; i < 2; ++i) stage_rc(tid * 16 + i * 8192, gR[i], gC[i]);
#define PG8_GOFF(dst, u) do { _Pragma("unroll") for (int _h = 0; _h < 2; ++_h) _Pragma("unroll") for (int _i = 0; _i < 2; ++_i) \
        dst[_h][_i] = S.row_off(u, _h * HALF + gR[_i]) + (unsigned)(gC[_i] * 2); } while (0)
#define PG8_STAGE_G(bufoff, gbase, vg) do { _Pragma("unroll") for (int _i = 0; _i < 2; ++_i) \
        __builtin_amdgcn_global_load_lds((const unsigned*)((const char*)(gbase) + (vg)[_i]), (LAS unsigned*)(lds + (bufoff) + ldsw + _i * 8192), 16, 0, 0); } while (0)
#define PG8_STAGE_A(bufoff, gb, h, nx) do { if constexpr (Sched::GATHER) { unsigned _v[2]; _v[0] = (nx) ? vgn[h][0] : vgc[h][0]; _v[1] = (nx) ? vgn[h][1] : vgc[h][1]; PG8_STAGE_G(bufoff, gb, _v); } \
        else PG8_STAGE(bufoff, (gb) + (h) * hstep, voffA); } while (0)
    const size_t kstep = (size_t)(BK * 2);
    const size_t hstep = (size_t)HALF * K * 2;
    const size_t tstep = 2 * hstep;
    const unsigned ldsw = (unsigned)wid * 1024u;
    const int aoff = lds_byte(wr * 64 + fr, fq * 8), boff = lds_byte(wc * 32 + fr, fq * 8);
#define PG8_SA(b, h) (((b) * 2 + (h)) * HTB)
#define PG8_SB(b, h) ((4 + (b) * 2 + (h)) * HTB)
#define PG8_STAGE(bufoff, gbase, voff) do { _Pragma("unroll") for (int _i = 0; _i < 2; ++_i) \
        __builtin_amdgcn_global_load_lds((const unsigned*)((const char*)(gbase) + (voff)[_i]), (LAS unsigned*)(lds + (bufoff) + ldsw + _i * 8192), 16, 0, 0); } while (0)
#define PG8_LDA(dst, b, h) do { _Pragma("unroll") for (int m = 0; m < 4; ++m) _Pragma("unroll") for (int k = 0; k < 2; ++k) dst[m][k] = *(const LAS bf16x8*)(lds + PG8_SA(b, h) + aoff + m * 2048 + k * 1024); } while (0)
#define PG8_LDB(dst, b, h) do { _Pragma("unroll") for (int n = 0; n < 2; ++n) _Pragma("unroll") for (int k = 0; k < 2; ++k) dst[n][k] = *(const LAS bf16x8*)(lds + PG8_SB(b, h) + boff + n * 2048 + k * 1024); } while (0)
#define PG8_MMA(ai, bj, At, Bt) do { __builtin_amdgcn_s_setprio(1); _Pragma("unroll") for (int m = 0; m < 4; ++m) _Pragma("unroll") for (int n = 0; n < 2; ++n) _Pragma("unroll") for (int k = 0; k < 2; ++k) \
        acc[ai][bj][m][n] = __builtin_amdgcn_mfma_f32_16x16x32_bf16(Bt[n][k], At[m][k], acc[ai][bj][m][n], 0, 0, 0); __builtin_amdgcn_s_setprio(0); } while (0)
#define PG8_WAIT_V(n) asm volatile("s_waitcnt vmcnt(" #n ")" ::: "memory")
#define PG8_WAIT_L(n) asm volatile("s_waitcnt lgkmcnt(" #n ")" ::: "memory")
#define PG8_BAR __builtin_amdgcn_s_barrier()
#define PG8_SCHED __builtin_amdgcn_sched_barrier(0)
    Unit cur, nxt; int ui = 0;
    if (!S.next(0, cur)) return;
    f32x4 acc[2][2][4][2];
#pragma unroll
    for (int a = 0; a < 2; ++a)
#pragma unroll
        for (int b = 0; b < 2; ++b)
#pragma unroll
            for (int m = 0; m < 4; ++m)
#pragma unroll
                for (int n = 0; n < 2; ++n) acc[a][b][m][n] = (f32x4){0.f, 0.f, 0.f, 0.f};
    bf16x8 At[4][2], B0[2][2], B1[2][2];
    const char* cA = (const char*)(cur.A ? cur.A : g.A) + (Sched::GATHER ? (size_t)0 : (size_t)cur.pm * tstep); const char* cB = (const char*)(cur.Bt ? cur.Bt : g.Bt) + (size_t)cur.bt * tstep;
    S.a_ready(cur);
    if constexpr (Sched::GATHER) { PG8_GOFF(vgc, cur); Unit n1; if (S.next(1, n1)) PG8_GOFF(vgn, n1); }
    if constexpr (SP2) {
        PG8_STAGE(PG8_SB(0, 0), cB, voffB); PG8_STAGE(PG8_SB(0, 1), cB + hstep, voffB); PG8_STAGE_A(PG8_SA(0, 0), cA, 0, false); PG8_STAGE_A(PG8_SA(0, 1), cA, 1, false);
        if (wr == 1) PG8_BAR;
        PG8_WAIT_V(2); PG8_BAR;
        PG8_STAGE(PG8_SB(1, 0), cB + kstep, voffB); PG8_STAGE_A(PG8_SA(1, 0), cA + kstep, 0, false); PG8_STAGE(PG8_SB(1, 1), cB + hstep + kstep, voffB);
        PG8_WAIT_V(6); PG8_BAR;
    } else {
        PG8_STAGE(PG8_SB(0, 0), cB, voffB); PG8_STAGE(PG8_SA(0, 0), cA, voffA); PG8_STAGE(PG8_SB(0, 1), cB + hstep, voffB); PG8_STAGE(PG8_SA(0, 1), cA + hstep, voffA);
        if (wr == 1) PG8_BAR;
        PG8_WAIT_V(4); PG8_BAR;
        PG8_STAGE(PG8_SB(1, 0), cB + kstep, voffB); PG8_STAGE(PG8_SA(1, 0), cA + kstep, voffA); PG8_STAGE(PG8_SB(1, 1), cB + hstep + kstep, voffB);
        PG8_WAIT_V(6); PG8_BAR;
    }
    for (;;) {
        const bool has_next = S.next(ui + 1, nxt);
        const char* nA = has_next ? (const char*)(nxt.A ? nxt.A : g.A) + (Sched::GATHER ? (size_t)0 : (size_t)nxt.pm * tstep) : cA;
        if constexpr (Sched::GATHER) { Unit n2; if (S.next(ui + 2, n2)) PG8_GOFF(vgnn, n2); if (!has_next) { vgn[0][0] = vgc[0][0]; vgn[0][1] = vgc[0][1]; vgn[1][0] = vgc[1][0]; vgn[1][1] = vgc[1][1]; } } const char* nB = has_next ? (const char*)(nxt.Bt ? nxt.Bt : g.Bt) + (size_t)nxt.bt * tstep : cB;
        for (int t = 0; t < nt; t += 2) {
            const bool last = (t == nt - 2);
            const char* a1 = cA + (size_t)(t + 1) * kstep;
            const char* a2 = last ? nA : cA + (size_t)(t + 2) * kstep; const char* b2 = last ? nB : cB + (size_t)(t + 2) * kstep;
            const char* a3 = a2 + kstep; const char* b3 = b2 + kstep;
            if (last && has_next) S.a_ready(nxt);
            if constexpr (SP2) {
            PG8_LDB(B0, 0, 0); PG8_LDB(B1, 0, 1); PG8_SCHED; PG8_LDA(At, 0, 0); PG8_STAGE_A(PG8_SA(1, 1), a1, 1, false);
            PG8_WAIT_V(8); PG8_WAIT_L(0); PG8_BAR; PG8_MMA(0, 0, At, B0); PG8_MMA(0, 1, At, B1); PG8_BAR; PG8_SCHED;
            PG8_LDA(At, 0, 1); PG8_STAGE(PG8_SB(0, 0), b2, voffB); PG8_STAGE(PG8_SB(0, 1), b2 + hstep, voffB); PG8_STAGE_A(PG8_SA(0, 0), a2, 0, last);
            PG8_WAIT_V(8); PG8_WAIT_L(0); PG8_BAR; PG8_MMA(1, 0, At, B0); PG8_MMA(1, 1, At, B1); PG8_BAR; PG8_SCHED;
            PG8_LDB(B0, 1, 0); PG8_LDB(B1, 1, 1); PG8_SCHED; PG8_LDA(At, 1, 0); PG8_STAGE_A(PG8_SA(0, 1), a2, 1, last);
            PG8_WAIT_V(8); PG8_WAIT_L(0); PG8_BAR; PG8_MMA(0, 0, At, B0); PG8_MMA(0, 1, At, B1); PG8_BAR; PG8_SCHED;
            PG8_LDA(At, 1, 1); PG8_STAGE(PG8_SB(1, 0), b3, voffB); PG8_STAGE(PG8_SB(1, 1), b3 + hstep, voffB); PG8_STAGE_A(PG8_SA(1, 0), a3, 0, last);
            PG8_WAIT_V(8); PG8_WAIT_L(0); PG8_BAR; PG8_MMA(1, 0, At, B0); PG8_MMA(1, 1, At, B1); PG8_BAR; PG8_SCHED;
            } else {
            PG8_LDB(B0, 0, 0); PG8_SCHED; PG8_LDA(At, 0, 0); PG8_STAGE(PG8_SA(1, 1), a1 + hstep, voffA);
            PG8_WAIT_L(8); PG8_BAR; PG8_WAIT_L(0); PG8_MMA(0, 0, At, B0); PG8_BAR; PG8_SCHED;
            PG8_LDB(B1, 0, 1); PG8_STAGE(PG8_SB(0, 0), b2, voffB);
            PG8_BAR; PG8_WAIT_L(0); PG8_MMA(0, 1, At, B1); PG8_BAR;
            PG8_LDA(At, 0, 1); PG8_STAGE(PG8_SA(0, 0), a2, voffA);
            PG8_BAR; PG8_WAIT_L(0); PG8_MMA(1, 0, At, B0); PG8_BAR; PG8_SCHED;
            PG8_STAGE(PG8_SB(0, 1), b2 + hstep, voffB);
            PG8_WAIT_V(6); PG8_BAR; PG8_MMA(1, 1, At, B1); PG8_BAR;
            PG8_LDB(B0, 1, 0); PG8_SCHED; PG8_LDA(At, 1, 0); PG8_STAGE(PG8_SA(0, 1), a2 + hstep, voffA);
            PG8_WAIT_L(8); PG8_BAR; PG8_WAIT_L(0); PG8_MMA(0, 0, At, B0); PG8_BAR; PG8_SCHED;
            PG8_LDB(B1, 1, 1); PG8_STAGE(PG8_SB(1, 0), b3, voffB);
            PG8_BAR; PG8_WAIT_L(0); PG8_MMA(0, 1, At, B1); PG8_BAR;
            PG8_LDA(At, 1, 1); PG8_STAGE(PG8_SA(1, 0), a3, voffA);
            PG8_BAR; PG8_WAIT_L(0); PG8_MMA(1, 0, At, B0); PG8_BAR; PG8_SCHED;
            PG8_STAGE(PG8_SB(1, 1), b3 + hstep, voffB);
            PG8_WAIT_V(6); PG8_BAR; PG8_MMA(1, 1, At, B1); PG8_BAR;
            }
        }
        if constexpr (ALIGN_EPI) { if (wr == 0) PG8_BAR; }
        if constexpr (!Epi::AFTER_DRAIN) { E(acc, cur, wr, wc, fr, fq); S.done(cur); }
        if (!has_next) break;
#pragma unroll
        for (int a = 0; a < 2; ++a)
#pragma unroll
            for (int b = 0; b < 2; ++b)
#pragma unroll
                for (int m = 0; m < 4; ++m)
#pragma unroll
                    for (int n = 0; n < 2; ++n) acc[a][b][m][n] = (f32x4){0.f, 0.f, 0.f, 0.f};
        cur = nxt; cA = nA; cB = nB; ++ui;
        if constexpr (Sched::GATHER) { vgc[0][0] = vgn[0][0]; vgc[0][1] = vgn[0][1]; vgc[1][0] = vgn[1][0]; vgc[1][1] = vgn[1][1]; vgn[0][0] = vgnn[0][0]; vgn[0][1] = vgnn[0][1]; vgn[1][0] = vgnn[1][0]; vgn[1][1] = vgnn[1][1]; }
        if constexpr (ALIGN_EPI) { if (wr == 1) PG8_BAR; }
    }
    PG8_WAIT_V(0);
    if constexpr (!ALIGN_EPI) { if (wr == 0) PG8_BAR; }
    PG8_BAR;
    if constexpr (Epi::AFTER_DRAIN) { E.fused(acc, cur, wr, wc, fr, fq, lds, wid, lane); S.done(cur); }
#undef PG8_SA
#undef PG8_SB
#undef PG8_STAGE
#undef PG8_STAGE_A
#undef PG8_STAGE_G
#undef PG8_GOFF
#undef PG8_LDA
#undef PG8_LDB
#undef PG8_MMA
#undef PG8_WAIT_V
#undef PG8_WAIT_L
#undef PG8_BAR
#undef PG8_SCHED
}
}
#define XB_TMO      128
#define XB_XCNT(j)  (256  + 64 * (j))
#define XB_XSUB(j)  (1280 + 64 * (j))
#define XB_XGEN(j)  (2304 + 64 * (j))
#define XB_TOP      3328
#define XB_TOPGEN   3392
#define XCD_BAR_WORDS 3456
#define XB_SPIN_CAP (1u << 18)

__device__ __forceinline__ unsigned xb_ld(unsigned* p)              { return __hip_atomic_load(p, __ATOMIC_RELAXED, __HIP_MEMORY_SCOPE_AGENT); }
__device__ __forceinline__ unsigned xb_add(unsigned* p, unsigned v) { return __hip_atomic_fetch_add(p, v, __ATOMIC_RELAXED, __HIP_MEMORY_SCOPE_AGENT); }
__device__ __forceinline__ unsigned xb_xcc_id() { return (unsigned)__builtin_amdgcn_s_getreg((3 << 11) | 20) & 0xFu; }
#define XB_SPIN(cond, bar) do { unsigned _sp = 0; while (cond) { __builtin_amdgcn_s_sleep(1); \
    if ((++_sp & 255u) == 0u) { if (xb_ld(&(bar)[XB_TMO])) break; if (_sp > XB_SPIN_CAP) { atomicAdd(&(bar)[XB_TMO], 1u); break; } } } } while (0)

struct XcdBarrier {
    unsigned* bar; unsigned x;
    volatile LAS unsigned* st;
};

__device__ __forceinline__ XcdBarrier xcd_barrier_post(unsigned* bar, volatile LAS unsigned* st) {
    XcdBarrier b; b.bar = bar; b.x = xb_xcc_id(); b.st = st;
    if (threadIdx.x == 0) (void)xb_add(&bar[XB_XCNT(b.x)], 1u);
    return b;
}
__device__ __forceinline__ void xcd_barrier_complete(unsigned* bar, unsigned x, unsigned& nloc, unsigned& nx) {
    const unsigned G = gridDim.x * gridDim.y * gridDim.z;
    unsigned sum, cnt, mine, sp = 0u;
    for (;;) {
        sum = 0u; cnt = 0u; mine = 0u;
#pragma unroll
        for (unsigned j = 0; j < 16; ++j) { const unsigned c = xb_ld(&bar[XB_XCNT(j)]); sum += c; cnt += (c > 0u) ? 1u : 0u; mine = (j == x) ? c : mine; }
        if (sum == G) break;
        __builtin_amdgcn_s_sleep(1);
        if ((++sp & 255u) == 0u) { if (xb_ld(&bar[XB_TMO])) break; if (sp > XB_SPIN_CAP) { atomicAdd(&bar[XB_TMO], 1u); break; } }
    }
    nloc = mine > 0u ? mine : 1u; nx = cnt > 0u ? cnt : 1u;
}

__device__ __forceinline__ void xcd_barrier(const XcdBarrier& b) {
    asm volatile("s_waitcnt vmcnt(0)" ::: "memory");
    __syncthreads();
    if (threadIdx.x == 0) {
        unsigned* bar = b.bar;
        __builtin_amdgcn_s_waitcnt(0);
        unsigned nloc = b.st[0], nx = b.st[1];
        if (nloc == 0u) { xcd_barrier_complete(bar, b.x, nloc, nx); b.st[0] = nloc; b.st[1] = nx; }
        const unsigned old = xb_add(&bar[XB_XSUB(b.x)], 1u);
        const unsigned gen = old / nloc;
        if (old + 1u == (gen + 1u) * nloc) {
            __builtin_amdgcn_fence(__ATOMIC_RELEASE, "agent");
            asm volatile("s_waitcnt vmcnt(0)" ::: "memory");
            const unsigned og = xb_add(&bar[XB_TOP], 1u);
            const unsigned tg = og / nx;
            if (og + 1u == (tg + 1u) * nx) xb_add(&bar[XB_TOPGEN], 1u);
            else XB_SPIN(xb_ld(&bar[XB_TOPGEN]) == tg, bar);
            __builtin_amdgcn_fence(__ATOMIC_ACQUIRE, "agent");
            xb_add(&bar[XB_XGEN(b.x)], 1u);
            asm volatile("s_waitcnt vmcnt(0)" ::: "memory");
        } else {
            XB_SPIN(xb_ld(&bar[XB_XGEN(b.x)]) == gen, bar);
            __builtin_amdgcn_fence(__ATOMIC_ACQUIRE, "agent");
            asm volatile("s_waitcnt vmcnt(0)" ::: "memory");
        }
    }
    __syncthreads();
}
namespace att {
constexpr int DQ = 64, DV = 128, NW = 8, QBLK = 32, KVBLK = 64, LD = 1024;
constexpr float QSCALE = 0.125f * 1.4426950408889634f;
constexpr float THRL = 11.0f;
constexpr int SHM_V = KVBLK * DV * 2, SHM_K = KVBLK * DQ * 2, SHM_ATTN = 2 * SHM_V + 2 * SHM_K + NW * 64 * 4;
#define AT_KSWZ(row, colB) ((row) * 128 + ((colB) ^ ((((row) >> 1) & 7) << 4)))
#define AT_SBAR() __builtin_amdgcn_sched_barrier(0)
#define AT_BAR() do { asm volatile("s_waitcnt lgkmcnt(0)" ::: "memory"); __builtin_amdgcn_s_barrier(); asm volatile("" ::: "memory"); } while (0)
__device__ __forceinline__ int crow(int r, int hi) { return (r & 3) + 8 * (r >> 2) + 4 * hi; }

constexpr int VT_LD = 8192;
struct CvCfg { const float* wg; const float* wu; const float* wd; bf16_t* wgu; bf16_t* wdt; int stride; };
struct CvState { int t, rem, it; const float* src; bf16_t* dst; f32x4 R; };
__device__ __forceinline__ void cv_setup(CvState& c, const CvCfg& g) {
  int it = c.it;
  if (it < 16384) { const int e = (it < 10240) ? (it >> 9) + 12 : (it >> 9) - 20; const int q = it & 511, kb = q >> 5, nb = q & 31;
    c.src = g.wd + (size_t)e * (1024 * 1024) + (size_t)(64 * kb) * 1024 + 32 * nb;
    c.dst = g.wdt + (size_t)e * (1024 * 1024) + (size_t)(32 * nb) * 1024 + 64 * kb; }
  else { it -= 16384; const int up = it >> 14; it &= 16383; const int e = it >> 9, q = it & 511, kb = q >> 5, nb = q & 31, n0 = 32 * nb;
    c.src = (up ? g.wu : g.wg) + (size_t)e * (1024 * 1024) + (size_t)(64 * kb) * 1024 + n0;
    c.dst = g.wgu + ((size_t)e * 2048 + (n0 >> 7) * 256 + up * 128 + (n0 & 127)) * 1024 + 64 * kb; }
}
constexpr int CV_PITCH = 68, CV_SCR_BYTES = 32 * CV_PITCH * 4;
__device__ __forceinline__ void cv_consume(CvState& c, LAS float* scr, int lane, f32x4& T0, f32x4& T1) {
  if (c.rem <= 0) return;
  const int t = c.t, l8 = lane >> 3, l7 = lane & 7;
  if (t >= 1 && t <= 8) { LAS float* w = scr + (4 * l7) * CV_PITCH + l8 + 8 * (t - 1); w[0] = c.R[0]; w[CV_PITCH] = c.R[1]; w[2 * CV_PITCH] = c.R[2]; w[3 * CV_PITCH] = c.R[3]; }
  if (t >= 8) { const LAS float* s = scr + (l8 + 8 * (t - 8)) * CV_PITCH + 8 * l7; T0 = *(const LAS f32x4*)s; T1 = *(const LAS f32x4*)(s + 4); }
}
__device__ __forceinline__ void cv_issue(CvState& c, const CvCfg& g, int lane, const f32x4& T0, const f32x4& T1) {
  if (c.rem <= 0) return;
  const int t = c.t, l8 = lane >> 3, l7 = lane & 7;
  if (t < 8) c.R = __builtin_nontemporal_load((const f32x4*)(c.src + (size_t)(8 * t) * 1024 + (l8 * 1024 + 4 * l7)));
  else { u32x4 o; o.x = cvt_pk_bf16(T0[0], T0[1]); o.y = cvt_pk_bf16(T0[2], T0[3]); o.z = cvt_pk_bf16(T1[0], T1[1]); o.w = cvt_pk_bf16(T1[2], T1[3]);
    __builtin_nontemporal_store(o, (u32x4*)(c.dst + (size_t)(8 * (t - 8)) * 1024 + (l8 * 1024 + 8 * l7))); }
  c.t = t + 1;
  if (c.t == 12) { c.t = 0; --c.rem; c.it += g.stride; if (c.rem > 0) cv_setup(c, g); }
}
template <int HALF_>
__device__ __forceinline__ void attn_half(const bf16_t* __restrict__ Qb, const bf16_t* __restrict__ Kh, const bf16_t* __restrict__ Vt, bf16_t* __restrict__ Ob, int seq, char* lds, CvState& cv, const CvCfg& cg, LAS float* scr, int pm, float lam, const float* __restrict__ dgp) {
  constexpr int KOFF = HALF_ ? 2 : 1;
  const int tid = threadIdx.x, wid = tid >> 6, lane = tid & 63, r32 = lane & 31, hi = lane >> 5;
  char* K_lds = lds; char* V_lds = lds + 2 * SHM_K;
  float* wsf = (float*)(lds + 2 * SHM_V + 2 * SHM_K) + wid * 64;
  float mhat = 0.f, l_reg = 0.f; f32x16 o[4] = {}; bf16x8 qr[4]; f32x16 negm = {};
  { const GAS char* QbU = (const GAS char*)(((unsigned long long)(unsigned)__builtin_amdgcn_readfirstlane((int)((unsigned long long)Qb >> 32)) << 32) | (unsigned long long)(unsigned)__builtin_amdgcn_readfirstlane((int)(unsigned)(unsigned long long)Qb));
    unsigned qoff0 = (unsigned)((wid * QBLK + r32) * LD + hi * 8) * 2u; asm volatile("" : "+v"(qoff0));
#pragma unroll
    for (int d0 = 0; d0 < 4; ++d0) qr[d0] = *(const GAS bf16x8*)(QbU + (qoff0 + (unsigned)(d0 * 32))); }
  const int kr = tid >> 3, kc = (tid & 7) * 8, kst = AT_KSWZ(kr, kc * 2);
  const int kx_ = ((r32 >> 1) & 7) << 4, kbase_ = (int)(uintptr_t)K_lds + r32 * 128;
  const int ka0 = kbase_ + ((hi * 16) ^ kx_), ka1 = kbase_ + ((32 + hi * 16) ^ kx_), ka2 = kbase_ + ((64 + hi * 16) ^ kx_), ka3 = kbase_ + ((96 + hi * 16) ^ kx_);
  const int NT = seq / KVBLK;
  bf16x8 kreg0, kreg1, vreg00, vreg01;
  const GAS char* KhU = (const GAS char*)(((unsigned long long)(unsigned)__builtin_amdgcn_readfirstlane((int)((unsigned long long)Kh >> 32)) << 32) | (unsigned long long)(unsigned)__builtin_amdgcn_readfirstlane((int)(unsigned)(unsigned long long)Kh));
  const GAS char* VtU = (const GAS char*)(((unsigned long long)(unsigned)__builtin_amdgcn_readfirstlane((int)((unsigned long long)Vt >> 32)) << 32) | (unsigned long long)(unsigned)__builtin_amdgcn_readfirstlane((int)(unsigned)(unsigned long long)Vt));
  unsigned koff0 = (unsigned)(kr * LD + kc) * 2u, voff0 = (unsigned)(kr * VT_LD + kc) * 2u;
  asm volatile("" : "+v"(koff0), "+v"(voff0));
#define AT_KLOAD(j) (*(const GAS bf16x8*)(KhU + (koff0 + (unsigned)(j) * (unsigned)(KVBLK * LD * 2))))
#define AT_VLOAD0(j) (*(const GAS bf16x8*)(VtU + (voff0 + (unsigned)(j) * (unsigned)(KVBLK * 2))))
#define AT_VLOAD1(j) (*(const GAS bf16x8*)(VtU + (voff0 + (unsigned)(j) * (unsigned)(KVBLK * 2) + (unsigned)(64 * VT_LD * 2))))
  kreg0 = AT_KLOAD(0); kreg1 = AT_KLOAD(1); vreg00 = AT_VLOAD0(0); vreg01 = AT_VLOAD1(0);
  *(bf16x8*)(K_lds + kst) = kreg0; *(bf16x8*)(K_lds + SHM_K + kst) = kreg1;
  *(bf16x8*)(V_lds + kst) = vreg00; *(bf16x8*)(V_lds + 8192 + kst) = vreg01;
  kreg0 = AT_KLOAD(2); vreg00 = AT_VLOAD0(1); vreg01 = AT_VLOAD1(1);
  f32x16 p0, p1; bf16x8 pa0, pa1, pa2, pa3;
  bf16x8 f0, f1, f2, f3, f4, f5, f6, f7;
  AT_BAR();
#define AT_RD(dst, i, PAR) do { if ((i) < 8) asm volatile("ds_read_b128 %0, %1 offset:%2" : "=&v"(dst) : "v"(AT_KA((i) >> 1)), "i"((PAR) * SHM_K + ((i) & 1) * 4096) : "memory"); \
    else asm volatile("ds_read_b128 %0, %1 offset:%2" : "=&v"(dst) : "v"(AT_KA(((i) - 8) >> 2)), "i"(2 * SHM_K + (1 - (PAR)) * SHM_V + (((i) - 8) & 3) * 4096) : "memory"); } while (0)
#define AT_KA(c) ((c) == 0 ? ka0 : (c) == 1 ? ka1 : (c) == 2 ? ka2 : ka3)
#define AT_PA(c) ((c) == 0 ? pa0 : (c) == 1 ? pa1 : (c) == 2 ? pa2 : pa3)
#define AT_MM(src, i) do { if ((i) < 2) { if ((i) == 0) p0 = __builtin_amdgcn_mfma_f32_32x32x16_bf16(src, qr[0], negm, 0, 0, 0); else p1 = __builtin_amdgcn_mfma_f32_32x32x16_bf16(src, qr[0], negm, 0, 0, 0); } \
    else if ((i) < 8) { if (((i) & 1) == 0) p0 = __builtin_amdgcn_mfma_f32_32x32x16_bf16(src, qr[((i) >> 1) & 3], p0, 0, 0, 0); else p1 = __builtin_amdgcn_mfma_f32_32x32x16_bf16(src, qr[((i) >> 1) & 3], p1, 0, 0, 0); } \
    else o[((i) - 8) & 3] = __builtin_amdgcn_mfma_f32_32x32x16_bf16(AT_PA(((i) - 8) >> 2), src, o[((i) - 8) & 3], 0, 0, 0); } while (0)
#define AT_WLX(n) do { asm volatile("s_waitcnt lgkmcnt(%0)" :: "n"(n) : "memory"); AT_SBAR(); } while (0)
#define AT_WL(n) do { if ((n) >= 5) asm volatile("s_waitcnt lgkmcnt(5)" ::: "memory"); else if ((n) == 4) asm volatile("s_waitcnt lgkmcnt(4)" ::: "memory"); else if ((n) == 3) asm volatile("s_waitcnt lgkmcnt(3)" ::: "memory"); \
    else if ((n) == 2) asm volatile("s_waitcnt lgkmcnt(2)" ::: "memory"); else if ((n) == 1) asm volatile("s_waitcnt lgkmcnt(1)" ::: "memory"); else asm volatile("s_waitcnt lgkmcnt(0)" ::: "memory"); AT_SBAR(); } while (0)
#define AT_STEP(i, N, PAR) do { AT_WL((N) - 1 - (i)); AT_MM(AT_F(i), i); AT_SBAR(); if ((i) + 6 < (N)) AT_RD(AT_F((i) + 6), (i) + 6, PAR); } while (0)
#define AT_F(i) f##i
#define AT_XPRE(PAR) do { AT_RD(f0, 0, PAR); AT_RD(f1, 1, PAR); AT_RD(f2, 2, PAR); AT_RD(f3, 3, PAR); AT_RD(f4, 4, PAR); AT_RD(f5, 5, PAR); AT_RD(f6, 6, PAR); AT_RD(f7, 7, PAR); } while (0)
#define AT_X(s, PAR) do { AT_SBAR(); AT_PRIO(1);  AT_PK4(p0, 0, pa0); AT_PK4(p0, 8, pa1); asm volatile("" : "+v"(pa0), "+v"(pa1)); AT_SBAR();  AT_MM(f0, 0); AT_SBAR(); AT_PK4(p1, 0, pa2); AT_PK4(p1, 8, pa3); asm volatile("" : "+v"(pa2), "+v"(pa3)); AT_SBAR();  AT_MM(f1, 1); AT_SBAR(); AT_MM(f2, 2); AT_SBAR(); AT_RD(f0, 8, PAR); AT_MM(f3, 3); AT_SBAR(); AT_RD(f1, 9, PAR); AT_MM(f4, 4); AT_SBAR(); AT_RD(f2, 10, PAR); AT_MM(f5, 5); AT_SBAR(); AT_RD(f3, 11, PAR); AT_MM(f6, 6); AT_SBAR(); AT_RD(f4, 12, PAR); AT_MM(f7, 7); AT_SBAR(); AT_RD(f5, 13, PAR); AT_WLX(5); AT_MM(f0, 8); AT_SBAR(); AT_RD(f6, 14, PAR); AT_WLX(5); AT_MM(f1, 9); AT_SBAR(); AT_RD(f7, 15, PAR); AT_WLX(5); AT_MM(f2, 10); AT_SBAR(); AT_RD(f0, 16, PAR); AT_WLX(5); AT_MM(f3, 11); AT_SBAR(); AT_RD(f1, 17, PAR); AT_WLX(5); AT_MM(f4, 12); AT_SBAR(); AT_RD(f2, 18, PAR); AT_WLX(5); AT_MM(f5, 13); AT_SBAR(); AT_RD(f3, 19, PAR); AT_WLX(5); AT_MM(f6, 14); AT_SBAR(); AT_RD(f4, 20, PAR); AT_WLX(5); AT_MM(f7, 15); AT_SBAR(); AT_RD(f5, 21, PAR); AT_WLX(5); AT_MM(f0, 16); AT_SBAR(); AT_RD(pa0, 22, PAR); AT_RD(f6, 6, 1 - (PAR)); AT_WLX(6); AT_MM(f1, 17); AT_SBAR(); AT_RD(pa1, 23, PAR); AT_RD(f7, 7, 1 - (PAR)); AT_WLX(7); AT_MM(f2, 18); AT_SBAR(); AT_RD(f0, 0, 1 - (PAR)); AT_WLX(7); AT_MM(f3, 19); AT_SBAR(); AT_RD(f1, 1, 1 - (PAR)); AT_WLX(7); AT_MM(f4, 20); AT_SBAR(); AT_RD(f2, 2, 1 - (PAR)); AT_WLX(7); AT_MM(f5, 21); AT_SBAR(); AT_RD(f3, 3, 1 - (PAR)); AT_WLX(7); AT_MM(pa0, 22); AT_SBAR(); AT_RD(f4, 4, 1 - (PAR)); AT_RD(f5, 5, 1 - (PAR)); AT_WLX(7); AT_MM(pa1, 23); AT_SBAR();  AT_PRIO(0); } while (0)
#define AT_XL(PAR) do { AT_SBAR(); AT_PRIO(1); AT_PK4(p0, 0, pa0); AT_PK4(p0, 8, pa1); asm volatile("" : "+v"(pa0), "+v"(pa1)); AT_SBAR(); AT_MM(f0, 0); AT_SBAR(); AT_PK4(p1, 0, pa2); AT_PK4(p1, 8, pa3); asm volatile("" : "+v"(pa2), "+v"(pa3)); AT_SBAR(); AT_MM(f1, 1); AT_SBAR(); AT_MM(f2, 2); AT_SBAR(); AT_RD(f0, 8, PAR); AT_MM(f3, 3); AT_SBAR(); AT_RD(f1, 9, PAR); AT_MM(f4, 4); AT_SBAR(); AT_RD(f2, 10, PAR); AT_MM(f5, 5); AT_SBAR(); AT_RD(f3, 11, PAR); AT_MM(f6, 6); AT_SBAR(); AT_RD(f4, 12, PAR); AT_MM(f7, 7); AT_SBAR(); AT_RD(f5, 13, PAR); AT_WL(15); AT_MM(f0, 8); AT_SBAR(); AT_RD(f6, 14, PAR); AT_WL(14); AT_MM(f1, 9); AT_SBAR(); AT_RD(f7, 15, PAR); AT_WL(13); AT_MM(f2, 10); AT_SBAR(); AT_RD(f0, 16, PAR); AT_WL(12); AT_MM(f3, 11); AT_SBAR(); AT_RD(f1, 17, PAR); AT_WL(11); AT_MM(f4, 12); AT_SBAR(); AT_RD(f2, 18, PAR); AT_WL(10); AT_MM(f5, 13); AT_SBAR(); AT_RD(f3, 19, PAR); AT_WL(9); AT_MM(f6, 14); AT_SBAR(); AT_RD(f4, 20, PAR); AT_WL(8); AT_MM(f7, 15); AT_SBAR(); AT_RD(f5, 21, PAR); AT_WL(7); AT_MM(f0, 16); AT_SBAR(); AT_RD(f6, 22, PAR); AT_WL(6); AT_MM(f1, 17); AT_SBAR(); AT_RD(f7, 23, PAR); AT_WL(5); AT_MM(f2, 18); AT_SBAR(); AT_WL(4); AT_MM(f3, 19); AT_SBAR(); AT_WL(3); AT_MM(f4, 20); AT_SBAR(); AT_WL(2); AT_MM(f5, 21); AT_SBAR(); AT_WL(1); AT_MM(f6, 22); AT_SBAR(); AT_WL(0); AT_MM(f7, 23); AT_SBAR(); AT_PRIO(0); } while (0)
#define AT_X0() do { AT_SBAR(); AT_PRIO(1); AT_MM(f0, 0); AT_SBAR(); AT_MM(f1, 1); AT_SBAR(); AT_MM(f2, 2); AT_SBAR(); AT_MM(f3, 3); AT_SBAR(); AT_MM(f4, 4); AT_SBAR(); AT_MM(f5, 5); AT_SBAR(); AT_MM(f6, 6); AT_SBAR(); AT_MM(f7, 7); AT_SBAR(); AT_XPRE(1); AT_PRIO(0); } while (0)
#define AT_S(i, r, N, PAR) do { AT_WL((N) - 1 - (i)); AT_MM(f##r, i); AT_SBAR(); } while (0)
#define AT_PRIO(n) do { if (n) __builtin_amdgcn_s_setprio(HALF_ ? 3 : 2); else __builtin_amdgcn_s_setprio(HALF_ ? 1 : 0); } while (0)
#define AT_PK4(P, BASE, OUT) do { u32x4 w = {cvt_pk_bf16(P[BASE + 0], P[BASE + 1]), cvt_pk_bf16(P[BASE + 2], P[BASE + 3]), cvt_pk_bf16(P[BASE + 4], P[BASE + 5]), cvt_pk_bf16(P[BASE + 6], P[BASE + 7])}; \
    OUT = *reinterpret_cast<bf16x8*>(&w); } while (0)
#define AT_Y(s, KPAR, FIRST) do { \
    { const int jk = (s) + KOFF + 1, jv = (s) + KOFF - 1; const bool ks = jk >= 3 && jk < NT, vs = jv >= 1 && jv < NT;        \
      f32x4 cvT0, cvT1; cv_consume(cv, scr, lane, cvT0, cvT1); \
      if (ks) { if (!(KPAR)) *(bf16x8*)(K_lds + SHM_K + kst) = kreg0; else *(bf16x8*)(K_lds + kst) = kreg0; } \
      if (vs) { if (KPAR) { *(bf16x8*)(V_lds + kst) = vreg00; *(bf16x8*)(V_lds + 8192 + kst) = vreg01; } else { *(bf16x8*)(V_lds + SHM_V + kst) = vreg00; *(bf16x8*)(V_lds + SHM_V + 8192 + kst) = vreg01; } } \
      asm volatile("" ::: "memory"); AT_SBAR(); \
      cv_issue(cv, cg, lane, cvT0, cvT1); \
      if (ks && jk + 1 < NT) kreg0 = AT_KLOAD(jk + 1);        \
      if (vs && jv + 1 < NT) { vreg00 = AT_VLOAD0(jv + 1); vreg01 = AT_VLOAD1(jv + 1); } } \
    { float pmax = fmaxf(p0[0], p1[0]); \
      _Pragma("unroll") for (int r = 1; r < 16; ++r) pmax = fmaxf(fmaxf(pmax, p0[r]), p1[r]); \
      { auto rr = __builtin_amdgcn_permlane32_swap(__float_as_uint(pmax), __float_as_uint(pmax), false, false); pmax = fmaxf(__uint_as_float(rr[0]), __uint_as_float(rr[1])); } \
      const bool first = (FIRST); \
      if (first || __any(pmax > THRL)) { \
        const float dl = first ? pmax : fmaxf(pmax, 0.f); mhat += dl; \
        _Pragma("unroll") for (int r = 0; r < 16; ++r) { p0[r] -= dl; p1[r] -= dl; } \
        if (!first) { const float f = __builtin_amdgcn_exp2f(-dl); l_reg *= f; if (hi == 0) wsf[r32] = f; asm volatile("s_waitcnt lgkmcnt(0)" ::: "memory"); \
          _Pragma("unroll") for (int d = 0; d < 4; ++d) _Pragma("unroll") for (int r = 0; r < 16; ++r) o[d][r] *= wsf[crow(r, hi)]; } } \
      { float nm = -mhat; asm volatile("" : "+v"(nm)); _Pragma("unroll") for (int r = 0; r < 16; ++r) negm[r] = nm; } \
      _Pragma("unroll") for (int r = 0; r < 16; ++r) { p0[r] = __builtin_amdgcn_exp2f(p0[r]); p1[r] = __builtin_amdgcn_exp2f(p1[r]); } \
      f32x2 ps2a = {p0[0], p0[1]}, ps2b = {p1[0], p1[1]}; \
      _Pragma("unroll") for (int r = 2; r < 16; r += 2) { ps2a += (f32x2){p0[r], p0[r + 1]}; ps2b += (f32x2){p1[r], p1[r + 1]}; }        \
      ps2a += ps2b; float ps = ps2a[0] + ps2a[1]; \
      { auto rr = __builtin_amdgcn_permlane32_swap(__float_as_uint(ps), __float_as_uint(ps), false, false); ps = __uint_as_float(rr[0]) + __uint_as_float(rr[1]); } \
      l_reg += ps; \
      } \
  } while (0)
  AT_XPRE(0);
  AT_BAR();
  *(bf16x8*)(K_lds + kst) = kreg0; kreg0 = AT_KLOAD(3);
  if (HALF_ == 1) AT_BAR();
  if (HALF_ == 1) __builtin_amdgcn_s_setprio(1);
  AT_X0(); AT_BAR();
  AT_Y(0, (KOFF & 1), true); AT_BAR();
  for (int s = 1; s + 1 < NT; s += 2) {
    AT_X(s, 1); AT_BAR();
    AT_Y(s, ((KOFF + 1) & 1), false); AT_BAR();
    AT_X(s + 1, 0); AT_BAR();
    AT_Y(s + 1, (KOFF & 1), false); AT_BAR();
  }
  AT_XL(1); AT_BAR();
  AT_Y(NT - 1, ((KOFF + 1) & 1), false); AT_BAR();
  { AT_SBAR();
    AT_PK4(p0, 0, pa0); AT_PK4(p0, 8, pa1); AT_PK4(p1, 0, pa2); AT_PK4(p1, 8, pa3);
    AT_RD(f0, 8, 0); AT_RD(f1, 9, 0); AT_RD(f2, 10, 0); AT_RD(f3, 11, 0); AT_RD(f4, 12, 0); AT_RD(f5, 13, 0);
    AT_S(8, 0, 24, 0);  AT_RD(f6, 14, 0);  AT_S(9, 1, 24, 0);  AT_RD(f7, 15, 0);  AT_S(10, 2, 24, 0); AT_RD(f0, 16, 0);  AT_S(11, 3, 24, 0); AT_RD(f1, 17, 0);
    AT_S(12, 4, 24, 0); AT_RD(f2, 18, 0);  AT_S(13, 5, 24, 0); AT_RD(f3, 19, 0);  AT_S(14, 6, 24, 0); AT_RD(f4, 20, 0);  AT_S(15, 7, 24, 0); AT_RD(f5, 21, 0);
    AT_S(16, 0, 24, 0); AT_RD(f6, 22, 0);  AT_S(17, 1, 24, 0); AT_RD(f7, 23, 0);  AT_S(18, 2, 24, 0); AT_S(19, 3, 24, 0); AT_S(20, 4, 24, 0); AT_S(21, 5, 24, 0); AT_S(22, 6, 24, 0); AT_S(23, 7, 24, 0); }
  if (HALF_ == 1) __builtin_amdgcn_s_setprio(0);
  if (HALF_ == 0) AT_BAR();
  if (hi == 0) wsf[32 + r32] = l_reg; asm volatile("s_waitcnt lgkmcnt(0)" ::: "memory");
  float rli[16];
#pragma unroll
  for (int r = 0; r < 16; ++r) rli[r] = __builtin_amdgcn_rcpf(wsf[32 + crow(r, hi)]);
  GAS char* ObU = (GAS char*)(((unsigned long long)(unsigned)__builtin_amdgcn_readfirstlane((int)((unsigned long long)Ob >> 32)) << 32) | (unsigned long long)(unsigned)__builtin_amdgcn_readfirstlane((int)(unsigned)(unsigned long long)Ob));
  unsigned ooff0 = (unsigned)((wid * QBLK + 4 * hi) * LD + r32) * 2u; asm volatile("" : "+v"(ooff0));
#define AT_OOFF(r, d0) (ooff0 + (unsigned)((((r & 3) + 8 * (r >> 2)) * LD + d0 * 32) * 2))
  if (pm == 0) {
#pragma unroll
    for (int r = 0; r < 16; ++r) {
#pragma unroll
      for (int d0 = 0; d0 < 4; ++d0) *(GAS bf16_t*)(ObU + AT_OOFF(r, d0)) = (bf16_t)(cvt_pk_bf16(o[d0][r] * rli[r], 0.f) & 0xffffu); }
  } else {
    unsigned short o1r[4][16];
#pragma unroll
    for (int r = 0; r < 16; ++r) {
#pragma unroll
      for (int d0 = 0; d0 < 4; ++d0) o1r[d0][r] = *(const GAS unsigned short*)(ObU + AT_OOFF(r, d0)); }
    float dgv[4];
#pragma unroll
    for (int d0 = 0; d0 < 4; ++d0) dgv[d0] = dgp[32 * d0 + r32] * (1.f - LAM_INIT);
#pragma unroll
    for (int r = 0; r < 16; ++r) {
      float ss = 0.f;
#pragma unroll
      for (int d0 = 0; d0 < 4; ++d0) { const float df = __uint_as_float((unsigned)o1r[d0][r] << 16) - lam * (o[d0][r] * rli[r]); o[d0][r] = df; ss += df * df; }
#pragma unroll
      for (int sft = 1; sft < 32; sft <<= 1) ss += __shfl_xor(ss, sft);
      const float rs = __builtin_amdgcn_rsqf(ss * (1.f / 128.f) + LN_EPS);
#pragma unroll
      for (int d0 = 0; d0 < 4; ++d0) *(GAS bf16_t*)(ObU + AT_OOFF(r, d0)) = (bf16_t)(cvt_pk_bf16(o[d0][r] * rs * dgv[d0], 0.f) & 0xffffu);
    }
  }
#undef AT_OOFF
#undef AT_KLOAD
#undef AT_XPRE
#undef AT_XL
#undef AT_VLOAD0
#undef AT_VLOAD1
#undef AT_RD
#undef AT_KA
#undef AT_PA
#undef AT_MM
#undef AT_WL
#undef AT_STEP
#undef AT_F
#undef AT_X
#undef AT_X0
#undef AT_S
#undef AT_XSTEPS
#undef AT_XSTEPS8
#undef AT_PRIO
#undef AT_PK4
#undef AT_Y
}
__device__ __forceinline__ void attn_dense_body(const bf16_t* __restrict__ Qb, const bf16_t* __restrict__ Kh, const bf16_t* __restrict__ Vh, bf16_t* __restrict__ Ob, int seq, char* lds, int half, CvState& cv, const CvCfg& cg, LAS float* scr, int pm, float lam, const float* __restrict__ dgp) {
  if (half == 0) attn_half<0>(Qb, Kh, Vh, Ob, seq, lds, cv, cg, scr, pm, lam, dgp); else attn_half<1>(Qb, Kh, Vh, Ob, seq, lds, cv, cg, scr, pm, lam, dgp);
  AT_BAR();
}
#undef AT_SBAR
#undef AT_BAR
}

namespace gla {
__device__ __forceinline__ int crow(int r, int hi) { return (r & 3) + 8 * (r >> 2) + 4 * hi; }
constexpr int P128 = 272, P64 = 144;
constexpr int L_QI = 0, L_KI = L_QI + 64 * P128, L_KST = L_KI + 64 * P128, L_VT = L_KST + 128 * P64, L_ST = L_VT + 128 * P64, L_ATT = L_ST + 128 * P128, L_DEC = L_ATT + 64 * P64, L_END = L_DEC + 512;
static_assert(L_END <= 131072, "GLA LDS map");
constexpr int NSEG = 8, CPS = 16;

__device__ __forceinline__ bf16x8 frag(const LAS unsigned char* p) { return *(const LAS bf16x8*)p; }
#define SWZ64(R, G) ((R) * P64 + 16 * ((G) ^ (((R) >> 4) & 7)))
#define GLA_MFMA(a, b, c) __builtin_amdgcn_mfma_f32_32x32x16_bf16((a), (b), (c), 0, 0, 0)
#define GLA_BAR() do { asm volatile("s_waitcnt lgkmcnt(0)" ::: "memory"); __builtin_amdgcn_s_barrier(); asm volatile("" ::: "memory"); } while (0)

__device__ __forceinline__ void g0_chunk(LAS unsigned char* lds, int ch, const bf16_t* h0, const bf16_t* wlr  , const float* wf_f, const float* bf_f, const float* wf_b, const float* bf_b, float* BF, float* BB) {
    const int tid = threadIdx.x, w = __builtin_amdgcn_readfirstlane(tid >> 6), lane = tid & 63, r = lane & 31, hh = lane >> 5;
    const int row0 = ch * 64, rh = w & 1, kq = w >> 1;
    LAS float* P = (LAS float*)lds;
    LAS float* LR = (LAS float*)(lds + 32768);
    {
        f32x16 acc = {};
        const bf16_t* ap = h0 + (size_t)(row0 + 32 * rh + r) * D + kq * 256 + 8 * hh;
        const bf16_t* bp = wlr + (size_t)r * D + kq * 256 + 8 * hh;
#pragma unroll 4
        for (int s = 0; s < 16; ++s) { const bf16x8 a = *(const bf16x8*)(ap + 16 * s), b = *(const bf16x8*)(bp + 16 * s); acc = GLA_MFMA(a, b, acc); }
#pragma unroll
        for (int q = 0; q < 16; ++q) P[(kq * 64 + 32 * rh + crow(q, hh)) * 32 + r] = acc[q];
    }
    GLA_BAR();
#pragma unroll
    for (int q = 0; q < 4; ++q) { const int idx = tid + 512 * q; LR[idx] = (P[idx] + P[2048 + idx]) + (P[4096 + idx] + P[6144 + idx]); }
    GLA_BAR();
    const int col = tid;
    float wf[16], wb[16];
#pragma unroll
    for (int q = 0; q < 16; ++q) { wf[q] = wf_f[q * 512 + col]; wb[q] = wf_b[q * 512 + col]; }
    const float b0 = bf_f[col], b1 = bf_b[col];
    float acc = 0.f;
    for (int c = 0; c < 64; ++c) {
        float x = b0;
#pragma unroll
        for (int q = 0; q < 16; ++q) x = fmaf(LR[c * 32 + q], wf[q], x);
        const float ls = fminf(x, 0.f) - __logf(1.0f + __expf(-fabsf(x)));
        acc += ls * 0.0625f;
        BF[(size_t)(row0 + c) * 512 + col] = acc;
    }
    acc = 0.f;
    for (int c = 63; c >= 0; --c) {
        float x = b1;
#pragma unroll
        for (int q = 0; q < 16; ++q) x = fmaf(LR[c * 32 + 16 + q], wb[q], x);
        const float ls = fminf(x, 0.f) - __logf(1.0f + __expf(-fabsf(x)));
        acc += ls * 0.0625f;
        BB[(size_t)(row0 + c) * 512 + col] = acc;
    }
    GLA_BAR();
}

struct Args { const bf16_t* qkg; const bf16_t* vg; const float* bf; const float* bb; float* seg; float* segd; bf16_t* of; bf16_t* ob; };

template <bool PASS2>
__device__ __forceinline__ void gla_unit(LAS unsigned char* lds, const Args& a, int unit) {
    const int tid = threadIdx.x, w = __builtin_amdgcn_readfirstlane(tid >> 6), lane = tid & 63, r = lane & 31, hh = lane >> 5;
    const int seg = unit & 7, es = (unit >> 3) & 1, dir = (unit >> 4) & 1, h = (unit >> 5) & 3, b = unit >> 7;
    if (!PASS2 && seg == NSEG - 1) return;
    const int db = w & 3, ebp = w >> 2;
    const int c = tid >> 3, g = tid & 7;
    const int clast = dir ? 0 : 63;
    const float* Bd = dir ? a.bb : a.bf;
    bf16_t* Od = dir ? a.ob : a.of;
    f32x16 S[2]; S[0] = f32x16{}; S[1] = f32x16{};
    float sumb[16];
#pragma unroll
    for (int j = 0; j < 16; ++j) sumb[j] = 0.f;
    if (PASS2) {
        for (int i = 0; i < seg; ++i) {
            const int up = unit - seg + i;
            const float* sp = a.seg + ((size_t)up * 8 + w) * 2048 + lane; const float* dp = a.segd + (size_t)up * 128 + 32 * db;
#pragma unroll
            for (int t = 0; t < 2; ++t)
#pragma unroll
                for (int q = 0; q < 16; ++q) S[t][q] = S[t][q] * dp[crow(q, hh)] + sp[(t * 16 + q) * 64];
        }
#pragma unroll
        for (int t = 0; t < 2; ++t)
#pragma unroll
            for (int g4 = 0; g4 < 4; ++g4) { u32x2 pk; pk.x = cvt_pk_bf16(S[t][4 * g4], S[t][4 * g4 + 1]); pk.y = cvt_pk_bf16(S[t][4 * g4 + 2], S[t][4 * g4 + 3]);
                *(LAS u32x2*)(lds + L_ST + (32 * (2 * ebp + t) + r) * P128 + (32 * db + 8 * g4 + 4 * hh) * 2) = pk; }
    }
    u32x4 q0 = {}, q1 = {}, k0, k1, v0, v1; f32x4 bv[4], bl[4];
#define GLA_LOADS(i_) do { const int n_ = seg * CPS + (i_), cn_ = dir ? (127 - n_) : n_; const size_t r0_ = (size_t)b * SEQ + (size_t)cn_ * 64; \
        const bf16_t* qp = a.qkg + (r0_ + c) * D + h * 128 + 16 * g; const bf16_t* kp = qp + 512; \
        const float* bp = Bd + (r0_ + c) * 512 + h * 128 + 16 * g; const float* blp = Bd + (r0_ + clast) * 512 + h * 128 + 16 * g; \
        const bf16_t* vp = a.vg + (r0_ + c) * D + h * 256 + es * 128 + 16 * g; \
        if (PASS2) { q0 = *(const u32x4*)qp; q1 = *(const u32x4*)(qp + 8); } \
        k0 = *(const u32x4*)kp; k1 = *(const u32x4*)(kp + 8); v0 = *(const u32x4*)vp; v1 = *(const u32x4*)(vp + 8); \
        _Pragma("unroll") for (int j = 0; j < 4; ++j) { bv[j] = *(const f32x4*)(bp + 4 * j); bl[j] = *(const f32x4*)(blp + 4 * j); } } while (0)
    GLA_LOADS(0);
    for (int i = 0; i < CPS; ++i) {
        const int n = seg * CPS + i, cn = dir ? (127 - n) : n; const size_t row0 = (size_t)b * SEQ + (size_t)cn * 64;
        {
            unsigned qw[8], kw[8], vw[8];
            qw[0] = q0.x; qw[1] = q0.y; qw[2] = q0.z; qw[3] = q0.w; qw[4] = q1.x; qw[5] = q1.y; qw[6] = q1.z; qw[7] = q1.w;
            kw[0] = k0.x; kw[1] = k0.y; kw[2] = k0.z; kw[3] = k0.w; kw[4] = k1.x; kw[5] = k1.y; kw[6] = k1.z; kw[7] = k1.w;
            vw[0] = v0.x; vw[1] = v0.y; vw[2] = v0.z; vw[3] = v0.w; vw[4] = v1.x; vw[5] = v1.y; vw[6] = v1.z; vw[7] = v1.w;
            unsigned qiw[8], kiw[8];
#pragma unroll
            for (int j2 = 0; j2 < 8; ++j2) {
                const float bA = bv[j2 >> 1][(2 * j2) & 3], bB = bv[j2 >> 1][(2 * j2 + 1) & 3];
                const float lA = bl[j2 >> 1][(2 * j2) & 3], lB = bl[j2 >> 1][(2 * j2 + 1) & 3];
                const float kA = bflo(kw[j2]), kB = bfhi(kw[j2]);
                const unsigned ks = cvt_pk_bf16(kA * fast_exp(lA - bA), kB * fast_exp(lB - bB));
                *(LAS unsigned short*)(lds + L_KST + (16 * g + 2 * j2) * P64 + 2 * (c ^ (g << 3))) = (unsigned short)(ks & 0xffffu);
                *(LAS unsigned short*)(lds + L_KST + (16 * g + 2 * j2 + 1) * P64 + 2 * (c ^ (g << 3))) = (unsigned short)(ks >> 16);
                *(LAS unsigned short*)(lds + L_VT + (16 * g + 2 * j2) * P64 + 2 * (c ^ (g << 3))) = (unsigned short)(vw[j2] & 0xffffu);
                *(LAS unsigned short*)(lds + L_VT + (16 * g + 2 * j2 + 1) * P64 + 2 * (c ^ (g << 3))) = (unsigned short)(vw[j2] >> 16);
                if (PASS2) {
                    qiw[j2] = cvt_pk_bf16(bflo(qw[j2]) * fast_exp(bA), bfhi(qw[j2]) * fast_exp(bB));
                    kiw[j2] = cvt_pk_bf16(kA * fast_exp(-bA), kB * fast_exp(-bB));
                }
                if (c == 0) { *(LAS float*)(lds + L_DEC + (16 * g + 2 * j2) * 4) = fast_exp(lA); *(LAS float*)(lds + L_DEC + (16 * g + 2 * j2 + 1) * 4) = fast_exp(lB); sumb[2 * j2] += lA; sumb[2 * j2 + 1] += lB; }
            }
            if (PASS2) {
                *(LAS u32x4*)(lds + L_QI + c * P128 + 32 * g) = (u32x4){qiw[0], qiw[1], qiw[2], qiw[3]}; *(LAS u32x4*)(lds + L_QI + c * P128 + 32 * g + 16) = (u32x4){qiw[4], qiw[5], qiw[6], qiw[7]};
                *(LAS u32x4*)(lds + L_KI + c * P128 + 32 * g) = (u32x4){kiw[0], kiw[1], kiw[2], kiw[3]}; *(LAS u32x4*)(lds + L_KI + c * P128 + 32 * g + 16) = (u32x4){kiw[4], kiw[5], kiw[6], kiw[7]};
            }
        }
        if (i + 1 < CPS) GLA_LOADS(i + 1);
        GLA_BAR();
        if (PASS2) {
            if (w < 4) {
                const int cb = w & 1, mb = w >> 1; f32x16 acc = {};
#pragma unroll
                for (int s = 0; s < 8; ++s) acc = GLA_MFMA(frag(lds + L_QI + (32 * cb + r) * P128 + (16 * s + 8 * hh) * 2), frag(lds + L_KI + (32 * mb + r) * P128 + (16 * s + 8 * hh) * 2), acc);
                const int mm = 32 * mb + r;
#pragma unroll
                for (int q = 0; q < 16; ++q) { const int cc = 32 * cb + crow(q, hh); const bool keep = dir ? (mm >= cc) : (mm <= cc);
                    *(LAS unsigned short*)(lds + L_ATT + cc * P64 + 2 * mm) = (unsigned short)(cvt_pk_bf16(keep ? acc[q] : 0.f, 0.f) & 0xffffu); }
            }
            GLA_BAR();
            {
                const int cb = w & 1, eb = w >> 1; f32x16 acc = {};
#pragma unroll
                for (int s = 0; s < 4; ++s) acc = GLA_MFMA(frag(lds + L_ATT + (32 * cb + r) * P64 + (16 * s + 8 * hh) * 2), frag(lds + L_VT + SWZ64(32 * eb + r, 2 * s + hh)), acc);
#pragma unroll
                for (int s = 0; s < 8; ++s) acc = GLA_MFMA(frag(lds + L_QI + (32 * cb + r) * P128 + (16 * s + 8 * hh) * 2), frag(lds + L_ST + (32 * eb + r) * P128 + (16 * s + 8 * hh) * 2), acc);
                bf16_t* op = Od + (row0 + 32 * cb) * D + h * 256 + es * 128 + 32 * eb + r;
#pragma unroll
                for (int q = 0; q < 16; ++q) op[(size_t)crow(q, hh) * D] = (bf16_t)(cvt_pk_bf16(acc[q], 0.f) & 0xffffu);
            }
        }
#pragma unroll
        for (int t = 0; t < 2; ++t) {
#pragma unroll
            for (int q = 0; q < 16; ++q) S[t][q] *= *(const LAS float*)(lds + L_DEC + (32 * db + crow(q, hh)) * 4);
#pragma unroll
            for (int s = 0; s < 4; ++s) S[t] = GLA_MFMA(frag(lds + L_KST + SWZ64(32 * db + r, 2 * s + hh)), frag(lds + L_VT + SWZ64(32 * (2 * ebp + t) + r, 2 * s + hh)), S[t]);
        }
        GLA_BAR();
        if (PASS2) {
#pragma unroll
            for (int t = 0; t < 2; ++t)
#pragma unroll
                for (int g4 = 0; g4 < 4; ++g4) { u32x2 pk; pk.x = cvt_pk_bf16(S[t][4 * g4], S[t][4 * g4 + 1]); pk.y = cvt_pk_bf16(S[t][4 * g4 + 2], S[t][4 * g4 + 3]);
                    *(LAS u32x2*)(lds + L_ST + (32 * (2 * ebp + t) + r) * P128 + (32 * db + 8 * g4 + 4 * hh) * 2) = pk; }
        }
    }
    if (!PASS2) {
        float* sp = a.seg + ((size_t)unit * 8 + w) * 2048 + lane;
#pragma unroll
        for (int t = 0; t < 2; ++t)
#pragma unroll
            for (int q = 0; q < 16; ++q) sp[(t * 16 + q) * 64] = S[t][q];
        if (c == 0) {
#pragma unroll
            for (int j = 0; j < 16; ++j) a.segd[(size_t)unit * 128 + 16 * g + j] = fast_exp(sumb[j]);
        }
    }
    GLA_BAR();
}
#undef GLA_MFMA
#undef GLA_LOADS
#undef SWZ64
#undef GLA_BAR
}

constexpr int NWAVES = 8;
constexpr size_t MiB = 1u << 20;
constexpr size_t WS_CTL = 0, CTL_ZERO_BYTES = 64 * 1024;
constexpr size_t WS_TOKE = 1 * MiB, WS_TOKG = WS_TOKE + 256 * 1024, WS_TOKP = WS_TOKG + 256 * 1024, WS_TOKD = WS_TOKP + 256 * 1024, WS_CTAB = WS_TOKD + 256 * 1024;
constexpr size_t WS_MS = 3 * MiB, WS_C12 = WS_MS + 256 * 1024, WS_SRC = WS_MS + 512 * 1024;
constexpr size_t WS_WIN = 5 * MiB;
constexpr size_t WS_WBRA = 22 * MiB, WS_WBRB = 24 * MiB, WS_WOUT = 26 * MiB;
constexpr size_t WS_H0 = 28 * MiB, WS_RG = 60 * MiB, WS_OF = 92 * MiB, WS_OB = 124 * MiB, WS_O1 = 156 * MiB, WS_O2 = 188 * MiB, WS_QD = 220 * MiB, WS_KD = 252 * MiB, WS_VD = 284 * MiB;
constexpr size_t WS_QKG = 320 * MiB, WS_VG = 352 * MiB, WS_BF = 384 * MiB, WS_BB = 416 * MiB, WS_SEG = 448 * MiB, WS_SEGD = 464 * MiB, WS_ROPE = 468 * MiB;
constexpr size_t WS_WGU = 320 * MiB, WS_WD = 448 * MiB;
constexpr size_t WS_SGG = WS_OB, WS_SGD = WS_O2, WS_MIXED = WS_RG;
constexpr size_t WS_XP = 5 * MiB, WS_ACT = 149 * MiB, WS_Y = 5 * MiB;
constexpr size_t WS_NEED = 512 * MiB;
constexpr int MAXTILES = 288;
constexpr int CW_BAR = 1024;
constexpr int CW_GLAD = 12288;
constexpr int CW_TCNT = 8192, CW_XMASK = 12320, CW_T8 = 12352, CW_T9 = 12864, CW_G1 = 13376, CW_T5 = 13632;
constexpr int RING_BYTES = 131072, LDSCTL_OFF = RING_BYTES, LDS_BYTES = 147456;
constexpr int LC_BAR = 0, LC_LCNT = 128, LC_LBASE = 256, LC_OFF = 384, LC_NT = 640, LC_TILE = 1024, LC_MY = 4096, LC_SIMD = 64, LC_MS = 8192;

#define LDS_WAIT() asm volatile("s_waitcnt lgkmcnt(0)" ::: "memory")
#define VM_WAIT() asm volatile("s_waitcnt vmcnt(0)" ::: "memory")
__device__ __forceinline__ unsigned pk2(float lo, float hi) { return cvt_pk_bf16(lo, hi); }
__device__ __forceinline__ float wave_sum(float v) {
#pragma unroll
    for (int o = 1; o < 64; o <<= 1) v += __shfl_xor(v, o);
    return v;
}
__device__ __forceinline__ float half_sum(float v) {
#pragma unroll
    for (int o = 1; o < 32; o <<= 1) v += __shfl_xor(v, o);
    return v;
}

struct Params {
    const float* x; const float* ln0_g; const float* ln0_b; const float* w_in; const float* wf_f; const float* bf_f; const float* wf_b; const float* bf_b;
    const float* gla_g; const float* lq1; const float* lk1; const float* lq2; const float* lk2; const float* diff_g;
    const float* w_bra; const float* w_brb; const float* w_out; const float* ln1_g; const float* ln1_b; const float* router_w; const float* router_b;
    const float* w_gate; const float* b_gate; const float* w_up; const float* b_up; const float* w_down; const float* b_down; const float* ln2_g; const float* ln2_b;
    float* out; unsigned char* ws; int ph_lo, ph_hi;
};

__device__ __forceinline__ void tr_item(const float* W, int pitch, int K, bf16_t* WT, LAS float* scr, int kb, int nb, int lane, bool rperm = false) {
    const int k0 = 64 * kb, n0 = 32 * nb;
#pragma unroll
    for (int i = 0; i < 8; ++i) { const int kk = 8 * i + (lane >> 3), c4 = (lane & 7) * 4; const f32x4 v = *(const f32x4*)(W + (size_t)(k0 + kk) * pitch + n0 + c4);
        scr[kk * 33 + c4] = v[0]; scr[kk * 33 + c4 + 1] = v[1]; scr[kk * 33 + c4 + 2] = v[2]; scr[kk * 33 + c4 + 3] = v[3]; }
    LDS_WAIT(); asm volatile("" ::: "memory");
    const int c = lane & 7;
#pragma unroll
    for (int j = 0; j < 4; ++j) { const int n = (lane >> 3) + 8 * j; const LAS float* s = scr + (8 * c) * 33 + n;
        u32x4 o; o.x = pk2(s[0 * 33], s[1 * 33]); o.y = pk2(s[2 * 33], s[3 * 33]); o.z = pk2(s[4 * 33], s[5 * 33]); o.w = pk2(s[6 * 33], s[7 * 33]);
        const int np = (rperm && n < 16) ? ((n & ~12) | ((n & 4) << 1) | ((n & 8) >> 1)) : n;
        *(u32x4*)(WT + (size_t)(n0 + np) * K + k0 + 8 * c) = o; }
    LDS_WAIT(); asm volatile("" ::: "memory");
}
__device__ __forceinline__ void ln_row(const float* xrow, const float* g, const float* b, int lane, f32x4 (&v)[4]) {
    float s = 0.f;
#pragma unroll
    for (int j = 0; j < 4; ++j) { v[j] = *(const f32x4*)(xrow + 256 * j + 4 * lane); s += (v[j][0] + v[j][1]) + (v[j][2] + v[j][3]); }
    const float mean = wave_sum(s) * (1.f / D); float s2 = 0.f;
#pragma unroll
    for (int j = 0; j < 4; ++j) { v[j] = v[j] - mean; s2 += (v[j][0] * v[j][0] + v[j][1] * v[j][1]) + (v[j][2] * v[j][2] + v[j][3] * v[j][3]); }
    const float rstd = 1.f / sqrtf(wave_sum(s2) * (1.f / D) + LN_EPS);
#pragma unroll
    for (int j = 0; j < 4; ++j) { const f32x4 gg = *(const f32x4*)(g + 256 * j + 4 * lane), bb = *(const f32x4*)(b + 256 * j + 4 * lane); v[j] = v[j] * rstd * gg + bb; }
}
__device__ __forceinline__ void store_row_bf16(bf16_t* orow, int lane, const f32x4 (&v)[4]) {
#pragma unroll
    for (int j = 0; j < 4; ++j) { u32x2 o; o.x = pk2(v[j][0], v[j][1]); o.y = pk2(v[j][2], v[j][3]); *(u32x2*)(orow + 256 * j + 4 * lane) = o; }
}

__global__ void __launch_bounds__(NWAVES * 64, 2) mk_fwd(Params p) {
    extern __shared__ __attribute__((aligned(16))) unsigned char lds_raw[];
    LAS unsigned char* lds = (LAS unsigned char*)lds_raw;
    LAS unsigned char* lctl = lds + LDSCTL_OFF;
    const int tid = threadIdx.x, lane = tid & 63, wave = __builtin_amdgcn_readfirstlane(tid >> 6);
    const int G = gridDim.x; const int bx = blockIdx.x; const int vcu = (G % 8 == 0) ? (bx % 8) * (G / 8) + bx / 8 : bx;
    const int gw = vcu * NWAVES + wave, NGW = G * NWAVES;
    unsigned char* ws = p.ws;
    unsigned* ctl = (unsigned*)(ws + WS_CTL);
    for (int u = tid; u < (LDS_BYTES - LDSCTL_OFF) / 4; u += NWAVES * 64) ((LAS unsigned*)lctl)[u] = 0u;
    __syncthreads();
    int att_half;
    att_half = wave >> 2;
    XcdBarrier bar = xcd_barrier_post(ctl + CW_BAR, (volatile LAS unsigned*)(lctl + LC_BAR));
    if (tid == 0) __hip_atomic_fetch_or(ctl + CW_XMASK + (vcu >> 5), 1u << bar.x, __ATOMIC_RELAXED, __HIP_MEMORY_SCOPE_AGENT);
    const int lo = p.ph_lo, hi = p.ph_hi;
#define IN(k) (lo <= (k) && (k) < hi)
#define SEAM(k) do { if (IN(k) && IN((k) + 1)) xcd_barrier(bar); } while (0)

    bf16_t* Wt_in = (bf16_t*)(ws + WS_WIN); bf16_t* Wbra_t = (bf16_t*)(ws + WS_WBRA); bf16_t* Wbrb_t = (bf16_t*)(ws + WS_WBRB); bf16_t* Wout_t = (bf16_t*)(ws + WS_WOUT);
    float* rope = (float*)(ws + WS_ROPE);
    bf16_t* H0 = (bf16_t*)(ws + WS_H0); bf16_t* RG = (bf16_t*)(ws + WS_RG); bf16_t* OF = (bf16_t*)(ws + WS_OF); bf16_t* OB = (bf16_t*)(ws + WS_OB);
    bf16_t* O1 = (bf16_t*)(ws + WS_O1); bf16_t* O2 = (bf16_t*)(ws + WS_O2); float* BBc = (float*)(ws + WS_BB); float* BFc = (float*)(ws + WS_BF);
    bf16_t* QKG = (bf16_t*)(ws + WS_QKG); bf16_t* VG = (bf16_t*)(ws + WS_VG); bf16_t* QD = (bf16_t*)(ws + WS_QD); bf16_t* KD = (bf16_t*)(ws + WS_KD); bf16_t* VD = (bf16_t*)(ws + WS_VD);
    bf16_t* Wgu_t = (bf16_t*)(ws + WS_WGU); bf16_t* Wd_t = (bf16_t*)(ws + WS_WD);
    bf16_t* SGG = (bf16_t*)(ws + WS_SGG); bf16_t* SGD = (bf16_t*)(ws + WS_SGD); bf16_t* MIXED = (bf16_t*)(ws + WS_MIXED);
    bf16_t* XP = (bf16_t*)(ws + WS_XP); bf16_t* ACT = (bf16_t*)(ws + WS_ACT); bf16_t* YB = (bf16_t*)(ws + WS_Y);
    int* TOKE = (int*)(ws + WS_TOKE); float* TOKG = (float*)(ws + WS_TOKG); int* TOKP = (int*)(ws + WS_TOKP); int* TOKD = (int*)(ws + WS_TOKD); int* CTAB = (int*)(ws + WS_CTAB);

#ifndef XR_P0
#define XR_P0 1
#endif
    if (IN(0)) for (int rep0 = 0; rep0 < XR_P0; ++rep0) {
        if (bx == 0) {
            LAS float* red = (LAS float*)(lds + 98304);
            const int e = tid & 31, part = tid >> 5; float s1 = 0.f, s2 = 0.f;
            for (int k = part * 64; k < part * 64 + 64; ++k) { const float w = p.router_w[k * 32 + e]; s1 += p.ln1_g[k] * w; s2 += p.ln1_b[k] * w; }
            red[part * 32 + e] = s1; red[512 + part * 32 + e] = s2;
            LDS_WAIT(); __syncthreads();
            if (tid < 64) { const int ee = tid & 31, wh = tid >> 5; float s = 0.f;
#pragma unroll
                for (int q = 0; q < 16; ++q) s += red[wh * 512 + q * 32 + ee];
                ((float*)(ws + WS_C12))[tid] = wh ? s + p.router_b[ee] : s; }
            __syncthreads();
        }
        LAS float* scr = (LAS float*)(lds + wave * 8448);
        constexpr int I1 = 16 * 96, I2 = 16 * 96, I3 = 16 * 1, I4 = 16 * 64, IB = 16 * 32;
        constexpr int NIT = I1 + I2 + I3 + I4 + 3 * IB;
        for (int it = gw; it < NIT; it += NGW) {
            int r = it;
            if (r < I1) { tr_item(p.w_in, NIN, D, Wt_in, scr, r / 96, r % 96, lane); continue; } r -= I1;
            if (r < I2) { const int nb2 = r % 96; tr_item(p.w_in + 3104, NIN, D, Wt_in + (size_t)3072 * D, scr, r / 96, nb2, lane, nb2 < 64 && !(nb2 & 1)); continue; } r -= I2;
            if (r < I3) { tr_item(p.w_in + 3072, NIN, D, Wt_in + (size_t)6144 * D, scr, r, 0, lane); continue; } r -= I3;
            if (r < I4) { tr_item(p.w_in + 6176, NIN, D, Wt_in + (size_t)6176 * D, scr, r / 64, r % 64, lane); continue; } r -= I4;
            if (r < IB) { tr_item(p.w_bra, D, D, Wbra_t, scr, r / 32, r % 32, lane); continue; } r -= IB;
            if (r < IB) { tr_item(p.w_brb, D, D, Wbrb_t, scr, r / 32, r % 32, lane); continue; } r -= IB;
            tr_item(p.w_out, D, D, Wout_t, scr, r / 32, r % 32, lane);
        }
        for (int m = gw; m < M; m += NGW) { f32x4 v[4]; ln_row(p.x + (size_t)m * D, p.ln0_g, p.ln0_b, lane, v); store_row_bf16(H0 + (size_t)m * D, lane, v); }
        for (int i = bx * 512 + tid; i < SEQ * 8; i += G * 512) {
            const int pos = i >> 3, f = i & 7;
            const double invf = f == 0 ? 1.0 : f == 1 ? 0.19392274474868576 : f == 2 ? 0.03760603093086393 : f == 3 ? 0.007292664737217109 : f == 4 ? 0.001414213562373095 : f == 5 ? 0.0002742481756762073 : f == 6 ? 5.318295896944988e-05 : 1.031338537721246e-05;
            const double t = (double)pos * invf * 0.15915494309189535; const float fr = (float)(t - floor(t));
            rope[i] = __builtin_amdgcn_cosf(fr); rope[SEQ * 8 + i] = __builtin_amdgcn_sinf(fr);
        }
    }
    SEAM(0);
    bool xcd_ok = false;
    if (lo == 0 && hi >= 15 && G == 256) { bool ok = true;
#pragma unroll
        for (int g8 = 0; g8 < 8; ++g8) { const unsigned mk = __hip_atomic_load(ctl + CW_XMASK + g8, __ATOMIC_RELAXED, __HIP_MEMORY_SCOPE_AGENT); ok = ok && (mk != 0u) && ((mk & (mk - 1u)) == 0u); }
        xcd_ok = ok; }
#define XCD_POST(word) do { VM_WAIT(); __syncthreads(); if (tid == 0) __hip_atomic_fetch_add(ctl + (word), 1u, __ATOMIC_RELAXED, __HIP_MEMORY_SCOPE_AGENT); } while (0)
#define XCD_WAIT(word, n) do { if (tid == 0) { unsigned _sp = 0; while (__hip_atomic_load(ctl + (word), __ATOMIC_RELAXED, __HIP_MEMORY_SCOPE_AGENT) < (unsigned)(n)) { __builtin_amdgcn_s_sleep(2); if (++_sp > (1u << 22)) { atomicAdd(ctl + CW_BAR + XB_TMO, 1u); break; } } __builtin_amdgcn_fence(__ATOMIC_ACQUIRE, "agent"); asm volatile("s_waitcnt vmcnt(0)" ::: "memory"); } __syncthreads(); } while (0)
    if (IN(1)) {
        pg8::Gemm g{H0, Wt_in, M, 6144, D};
        pg8::EpiIn E{QKG, VG, RG, QD, KD, VD, rope};
        pg8::InProjOrder S; S.S0.init(M, 6144, G, bx); S.c = vcu; S.fast = (G == 256);
        pg8::gemm_phase<pg8::EpiIn, pg8::InProjOrder, true, true>(lds, g, S, E);
    }
    if (IN(2)) {
#ifndef XR_G0
#define XR_G0 1
#endif
        for (int rep = 0; rep < XR_G0; ++rep) for (int ch = vcu; ch < M / 64; ch += G) gla::g0_chunk(lds, ch, H0, Wt_in + (size_t)6144 * D, p.wf_f, p.bf_f, p.wf_b, p.bf_b, BFc, BBc);
    }
    SEAM(2);
    const gla::Args ga{QKG, VG, BFc, BBc, (float*)(ws + WS_SEG), (float*)(ws + WS_SEGD), OF, OB};
#ifndef XR_GLA1
#define XR_GLA1 1
#endif
    if (IN(3)) { for (int u = vcu; u < 256; u += G) gla::gla_unit<false>(lds, ga, u);
        if (xcd_ok) XCD_POST(CW_G1 + 8 * (vcu >> 3)); }
    if (!xcd_ok) SEAM(3);
    if (IN(4)) {
#ifndef XR_GLA2
#define XR_GLA2 1
#endif
        if (xcd_ok) XCD_WAIT(CW_G1 + 8 * (vcu >> 3), 8);
        for (int u = vcu; u < 256; u += G) gla::gla_unit<true>(lds, ga, u);
        __syncthreads();
        if (tid == 0) { __threadfence(); __hip_atomic_fetch_add(ctl + CW_GLAD, 1u, __ATOMIC_RELEASE, __HIP_MEMORY_SCOPE_AGENT); }
        att::CvCfg cg{p.w_gate, p.w_up, p.w_down, Wgu_t, Wd_t, NGW};
        att::CvState cv; cv.R = (f32x4){0.f, 0.f, 0.f, 0.f}; cv.t = 0; cv.rem = 0; cv.it = 0; cv.src = p.w_down; cv.dst = Wd_t;
        LAS float* cscr = (LAS float*)(lds + 53248 + wave * att::CV_SCR_BYTES);
        const bool bg = (G == 256);
        float lam;
        { const float a1 = wave_sum(p.lq1[lane] * p.lk1[lane]), a2 = wave_sum(p.lq2[lane] * p.lk2[lane]); lam = expf(a1) - expf(a2) + LAM_INIT; }
        int round = 0;
        for (int S2 = vcu; S2 < 512; S2 += G) {
            const int bh = S2 >> 5, qb = S2 & 31, b = bh >> 3, h = bh & 7;
            const size_t rb = (size_t)b * SEQ;
            for (int pm = 0; pm < 2; ++pm, ++round) {
                if (bg) {
                    if (round == 1) { if (tid == 0) { { unsigned _sp = 0; while (__hip_atomic_load(ctl + CW_GLAD, __ATOMIC_RELAXED, __HIP_MEMORY_SCOPE_AGENT) < (unsigned)G) { __builtin_amdgcn_s_sleep(8); if (++_sp > (1u << 21)) { atomicAdd(ctl + CW_BAR + XB_TMO, 1u); break; } } } } __syncthreads(); }
                    const int j0 = round == 0 ? 0 : round == 1 ? 5 : round == 2 ? 12 : 18;
                    cv.t = 0; cv.rem = round == 0 ? 5 : round == 1 ? 7 : 6; cv.it = gw + NGW * j0; att::cv_setup(cv, cg);
                }
                att::attn_dense_body(QD + (rb + qb * 256) * D + h * 128 + pm * 64, KD + rb * D + h * 128 + pm * 64, VD + (size_t)((b * 8 + h) * 128) * SEQ, O1 + (rb + qb * 256) * D + h * 128, SEQ, (char*)lds_raw, att_half, cv, cg, cscr, pm, lam, p.diff_g);
            }
        }
        if (!bg) {
            if (tid == 0) { { unsigned _sp = 0; while (__hip_atomic_load(ctl + CW_GLAD, __ATOMIC_RELAXED, __HIP_MEMORY_SCOPE_AGENT) < (unsigned)G) { __builtin_amdgcn_s_sleep(8); if (++_sp > (1u << 21)) { atomicAdd(ctl + CW_BAR + XB_TMO, 1u); break; } } } } __syncthreads();
            LAS float* scr = (LAS float*)(lds + wave * 8448);
            for (int it = gw; it < NE * 3 * 512; it += NGW) {
                const int e = it / 1536, r = it % 1536, mat = r / 512, q = r % 512, kb = q / 32, nb = q % 32, n0 = 32 * nb;
                if (mat == 0) tr_item(p.w_gate + (size_t)e * D * DFF, DFF, D, Wgu_t + ((size_t)e * 2048 + (n0 >> 7) * 256 + (n0 & 127) - n0) * D, scr, kb, nb, lane);
                else if (mat == 1) tr_item(p.w_up + (size_t)e * D * DFF, DFF, D, Wgu_t + ((size_t)e * 2048 + (n0 >> 7) * 256 + 128 + (n0 & 127) - n0) * D, scr, kb, nb, lane);
                else tr_item(p.w_down + (size_t)e * DFF * D, D, DFF, Wd_t + (size_t)e * 1024 * DFF, scr, kb, nb, lane);
            }
        }
    }
    SEAM(4);
    if (IN(5)) {
        const f32x4 gg = *(const f32x4*)(p.gla_g + 4 * lane);
        const int nrow = xcd_ok ? 8 : (M + NGW - 1 - gw) / NGW;
        for (int i5 = 0; i5 < nrow; ++i5) {
            const int m = xcd_ok ? (vcu >> 5) * 2048 + (vcu & 31) * 64 + wave * 8 + i5 : gw + i5 * NGW;
            const size_t ro = (size_t)m * D + 4 * lane;
#pragma unroll
            for (int j = 0; j < 4; ++j) {
                const u32x2 a = *(const u32x2*)(OF + ro + 256 * j), b = *(const u32x2*)(OB + ro + 256 * j), rg = *(const u32x2*)(RG + ro + 256 * j);
                f32x4 xv; xv[0] = bflo(a.x) + bflo(b.x); xv[1] = bfhi(a.x) + bfhi(b.x); xv[2] = bflo(a.y) + bflo(b.y); xv[3] = bfhi(a.y) + bfhi(b.y);
                const float ss = wave_sum((xv[0] * xv[0] + xv[1] * xv[1]) + (xv[2] * xv[2] + xv[3] * xv[3]));
                const float rs = 1.f / sqrtf(ss * (1.f / 256.f) + LN_EPS);
                u32x2 o; o.x = pk2(xv[0] * rs * gg[0] * bflo(rg.x), xv[1] * rs * gg[1] * bfhi(rg.x)); o.y = pk2(xv[2] * rs * gg[2] * bflo(rg.y), xv[3] * rs * gg[3] * bfhi(rg.y));
                *(u32x2*)(OF + ro + 256 * j) = o;
            }
        }
        if (xcd_ok) XCD_POST(CW_T5 + 8 * ((vcu >> 5) * 8 + ((vcu & 31) >> 2)));
    }
    if (!xcd_ok) SEAM(5);
    if (IN(6)) {
        pg8::Gemm g{H0, Wt_in + (size_t)6176 * D, M, D, D};
        pg8::ChainOrder S; S.S0.init(M, D, G, bx); S.ws = ws;
        S.a_h0 = (long)WS_H0; S.a_of = (long)WS_OF; S.a_o1 = (long)WS_O1; S.b_gate = (long)(WS_WIN + (size_t)6176 * D * 2); S.b_bra = (long)WS_WBRA; S.b_brb = (long)WS_WBRB;
        pg8::EpiChain E{SGG, SGD, p.out, MIXED};
        if (xcd_ok) { pg8::Unit u0; S.S0.next(0, u0); XCD_WAIT(CW_T5 + 8 * u0.pm, 4); }
        pg8::gemm_phase<pg8::EpiChain, pg8::ChainOrder, true, true>(lds, g, S, E);
        if (xcd_ok) { pg8::Unit u0; S.S0.next(0, u0); XCD_POST(CW_T8 + 8 * u0.pm); }
    }
    if (!xcd_ok) SEAM(8);
    if (IN(9)) {
        pg8::Gemm g{MIXED, Wout_t, M, D, D}; pg8::StaticOrder S; S.init(M, D, G, bx);
        pg8::EpiResid E{H0, p.out};
        pg8::Unit u0; S.next(0, u0);
        if (xcd_ok) XCD_WAIT(CW_T8 + 8 * u0.pm, 4);
        pg8::gemm_phase<pg8::EpiResid, pg8::StaticOrder, true, true>(lds, g, S, E);
        if (xcd_ok) XCD_POST(CW_T9 + 8 * u0.pm);
    }
    if (!xcd_ok) SEAM(9);
    if (IN(10)) {
        LAS float* WR = (LAS float*)lds;
        LAS unsigned* lcnt = (LAS unsigned*)(lctl + LC_LCNT);
        LAS float* msl = (LAS float*)(lctl + LC_MS);
        float* MS = (float*)(ws + WS_MS); const float* C12 = (const float*)(ws + WS_C12);
        for (int blk = vcu; blk < M / 64; blk += G) {
            if (xcd_ok) XCD_WAIT(CW_T9 + 8 * (blk >> 2), 4);
            if (tid < 32) lcnt[tid] = 0u;
            { const int r3 = lane >> 3, k3 = ((r3 & 1) << 2) | (r3 & 2) | (r3 >> 2);
              const char* gsrc = (const char*)p.router_w + (size_t)(k3 * 32 + 4 * (lane & 7)) * 4;
#pragma unroll 4
              for (int n = wave; n < 128; n += NWAVES) __builtin_amdgcn_global_load_lds((const unsigned*)(gsrc + (size_t)n * 1024), (LAS unsigned*)(lds + n * 1024), 16, 0, 0); }
            for (int rr = 0; rr < 8; rr += 4) {
                f32x4 v[4][4];
#pragma unroll
                for (int r2 = 0; r2 < 4; ++r2) { const float* xrow = p.out + (size_t)(blk * 64 + wave * 8 + rr + r2) * D;
#pragma unroll
                    for (int j = 0; j < 4; ++j) v[r2][j] = *(const f32x4*)(xrow + 256 * j + 4 * lane); }
#pragma unroll
                for (int r2 = 0; r2 < 4; ++r2) { const int lr = wave * 8 + rr + r2, m = blk * 64 + lr;
                    float s = 0.f;
#pragma unroll
                    for (int j = 0; j < 4; ++j) s += (v[r2][j][0] + v[r2][j][1]) + (v[r2][j][2] + v[r2][j][3]);
                    const float mean = wave_sum(s) * (1.f / D); float s2 = 0.f;
#pragma unroll
                    for (int j = 0; j < 4; ++j) { v[r2][j] = v[r2][j] - mean; s2 += (v[r2][j][0] * v[r2][j][0] + v[r2][j][1] * v[r2][j][1]) + (v[r2][j][2] * v[r2][j][2] + v[r2][j][3] * v[r2][j][3]); }
                    const float rstd = 1.f / sqrtf(wave_sum(s2) * (1.f / D) + LN_EPS);
                    if (lane == 0) { msl[lr * 2] = mean; msl[lr * 2 + 1] = rstd; *(f32x2*)(MS + (size_t)m * 2) = (f32x2){mean, rstd}; }
#pragma unroll
                    for (int j = 0; j < 4; ++j) { const f32x4 gg = *(const f32x4*)(p.ln1_g + 256 * j + 4 * lane), bb = *(const f32x4*)(p.ln1_b + 256 * j + 4 * lane); v[r2][j] = v[r2][j] * rstd * gg + bb; }
                    store_row_bf16((bf16_t*)(ws + pg8::h1b_off(m)), lane, v[r2]); }
            }
            VM_WAIT(); LDS_WAIT(); __syncthreads();
            f32x16 acc = {};
            { const int rb = wave & 1, kq = wave >> 1, i = lane & 31, kh = lane >> 5;
              const float* ap = p.out + (size_t)(blk * 64 + 32 * rb + i) * D + 256 * kq + 4 * kh;
              const float* gp = p.ln1_g + 256 * kq + 4 * kh;
              const LAS float* bp = WR + (256 * kq) * 32 + lane;
#pragma unroll 8
              for (int t = 0; t < 32; ++t) { const f32x4 a4 = *(const f32x4*)(ap + 8 * t) * *(const f32x4*)(gp + 8 * t);
                  const float b0 = bp[t * 256], b1 = bp[t * 256 + 128], b2 = bp[t * 256 + 64], b3 = bp[t * 256 + 192];
                  acc = __builtin_amdgcn_mfma_f32_32x32x2f32(a4[0], b0, acc, 0, 0, 0); acc = __builtin_amdgcn_mfma_f32_32x32x2f32(a4[1], b1, acc, 0, 0, 0);
                  acc = __builtin_amdgcn_mfma_f32_32x32x2f32(a4[2], b2, acc, 0, 0, 0); acc = __builtin_amdgcn_mfma_f32_32x32x2f32(a4[3], b3, acc, 0, 0, 0); } }
            LDS_WAIT(); __syncthreads();
            LAS float* PS = (LAS float*)lds;
            LAS float* LG = (LAS float*)(lds + 32768);
            { const int rb = wave & 1, kq = wave >> 1, j = lane & 31, hh = lane >> 5;
#pragma unroll
              for (int q = 0; q < 16; ++q) PS[(kq * 64 + 32 * rb + ((q & 3) + 8 * (q >> 2) + 4 * hh)) * 32 + j] = acc[q]; }
            LDS_WAIT(); __syncthreads();
            { const int e = tid & 31; const float c1 = C12[e], c2 = C12[32 + e];
#pragma unroll
              for (int q = 0; q < 4; ++q) { const int idx = tid + 512 * q, row = idx >> 5; const float raw = (PS[idx] + PS[2048 + idx]) + (PS[4096 + idx] + PS[6144 + idx]);
                  LG[row * 33 + e] = msl[row * 2 + 1] * (raw - msl[row * 2] * c1) + c2; } }
            LDS_WAIT(); __syncthreads();
            if (wave == 0) {
                const int m = blk * 64 + lane; float lg[32];
#pragma unroll
                for (int e = 0; e < 32; ++e) lg[e] = LG[lane * 33 + e];
                float tv[4]; int ti[4];
#pragma unroll
                for (int k = 0; k < 4; ++k) { float bv = -INFINITY; int bi = 0;
#pragma unroll
                    for (int e = 0; e < 32; ++e) { const bool used = (k > 0 && ti[0] == e) || (k > 1 && ti[1] == e) || (k > 2 && ti[2] == e); const bool take = !used && (lg[e] > bv); bv = take ? lg[e] : bv; bi = take ? e : bi; }
                    tv[k] = bv; ti[k] = bi; }
                const float e1 = __expf(tv[1] - tv[0]), e2 = __expf(tv[2] - tv[0]), e3 = __expf(tv[3] - tv[0]); const float inv = 1.f / (1.f + e1 + e2 + e3);
                int pos[4];
#pragma unroll
                for (int k = 0; k < 4; ++k) pos[k] = (int)__hip_atomic_fetch_add(lcnt + ti[k], 1u, __ATOMIC_RELAXED, __HIP_MEMORY_SCOPE_WORKGROUP);
                *(u32x4*)(TOKE + m * 4) = (u32x4){(unsigned)ti[0], (unsigned)ti[1], (unsigned)ti[2], (unsigned)ti[3]};
                *(f32x4*)(TOKG + m * 4) = (f32x4){inv, e1 * inv, e2 * inv, e3 * inv};
                *(u32x4*)(TOKP + m * 4) = (u32x4){(unsigned)pos[0], (unsigned)pos[1], (unsigned)pos[2], (unsigned)pos[3]};
            }
            LDS_WAIT(); __syncthreads();
            if (tid < 32) CTAB[blk * 32 + tid] = (int)lcnt[tid];
            __syncthreads();
        }
    }
    SEAM(10);
    LAS int* l_off = (LAS int*)(lctl + LC_OFF); LAS int* l_nt = (LAS int*)(lctl + LC_NT); LAS int* l_tile = (LAS int*)(lctl + LC_TILE);
    LAS int* l_tot = (LAS int*)(lctl + LC_LCNT); LAS int* l_base = (LAS int*)(lctl + LC_LBASE);
    if (lo <= 13 && hi > 11) {
        if (tid < 32) { int tot = 0;
#pragma unroll 8
            for (int b2 = 0; b2 < M / 64; ++b2) tot += CTAB[b2 * 32 + tid];
            l_tot[tid] = tot; }
        LDS_WAIT(); __syncthreads();
        if (tid == 0) { int off = 0, nt = 0;
            for (int e = 0; e < NE; ++e) { const int c = l_tot[e]; l_off[e] = off; const int t = (c + 255) >> 8;
                for (int i = 0; i < t; ++i) l_tile[nt + i] = e; nt += t; off += t * 256; }
            l_off[NE] = off; l_nt[0] = nt; }
        LDS_WAIT(); __syncthreads();
    }
#ifndef XR_P11
#define XR_P11 1
#endif
    int* SRCT = (int*)(ws + WS_SRC);
    if (IN(11)) for (int rep11 = 0; rep11 < XR_P11; ++rep11) {
        for (int blk = vcu; blk < M / 64; blk += G) {
            if (tid < 32) { int base = 0;
#pragma unroll 8
                for (int b2 = 0; b2 < blk; ++b2) base += CTAB[b2 * 32 + tid];
                l_base[tid] = base; }
            LDS_WAIT(); __syncthreads();
            if (tid < 256) { const int idx = blk * 256 + tid; const int e = TOKE[idx]; const int dest = l_off[e] + l_base[e] + TOKP[idx]; TOKD[idx] = dest; SRCT[dest] = idx >> 2; }
            __syncthreads();
        }
        {
            const int e = vcu & 31, sub = vcu >> 5, nsub = (G + 31) >> 5;
            const int r0 = l_off[e] + l_tot[e], r1 = l_off[e + 1];
            for (int rr = r0 + sub * 512 + tid; rr < r1; rr += nsub * 512) SRCT[rr] = 0;
        }
    }
    SEAM(11);
    int f13 = 0;
    { const int ntl = l_nt[0]; const long n12 = 8L * ntl, full12 = (n12 / G) * G; const int l12 = (int)(n12 - full12);
      if (lo <= 12 && hi > 13 && l12 > 0) { long f = G - l12; if (f > 4L * ntl) f = 4L * ntl; if ((f + 3) / 4 > full12 / 8) f = 0; f13 = (int)f; }
      if (IN(12)) {
        pg8::Gemm g{(const bf16_t*)ws, Wgu_t, MAXTILES * 256, 2048, D};
        { pg8::MoeGatherOrder S{ntl, 8, G, vcu, l_tile, SRCT, (lo <= 12 && hi > 13) ? full12 : n12};
          pg8::EpiSwiglu E{p.b_gate, p.b_up, ACT};
          pg8::gemm_phase<pg8::EpiSwiglu, pg8::MoeGatherOrder, true, true>(lds, g, S, E); }
        if (lo <= 12 && hi > 13 && l12 > 0) {
            xcd_barrier(bar);
            pg8::MoeMixOrder S{vcu, l12, f13, full12, l_tile, SRCT, (unsigned)WS_ACT, ws, (long)WS_WGU, (long)WS_WD};
            pg8::EpiMoe E{pg8::EpiSwiglu{p.b_gate, p.b_up, ACT}, pg8::EpiBiasBf16{p.b_down, YB}};
            pg8::gemm_phase<pg8::EpiMoe, pg8::MoeMixOrder, true, true>(lds, g, S, E);
        }
      }
    }
    SEAM(12);
    if (IN(13)) {
        pg8::Gemm g{ACT, Wd_t, MAXTILES * 256, D, DFF}; pg8::MoeOrder S{l_nt[0], 4, G, vcu, l_tile, (long)f13};
        pg8::EpiBiasBf16 E{p.b_down, YB};
        pg8::gemm_phase<pg8::EpiBiasBf16, pg8::MoeOrder, true, true>(lds, g, S, E);
    }
    SEAM(13);
    if (IN(14)) {
        const bool bad = __hip_atomic_load(ctl + CW_BAR + XB_TMO, __ATOMIC_RELAXED, __HIP_MEMORY_SCOPE_AGENT) != 0u;
#ifndef XR_P14
#define XR_P14 1
#endif
        for (int rep14 = 0; rep14 < XR_P14; ++rep14) { float* outp = (rep14 + 1 < XR_P14) ? (float*)ACT : p.out;
        f32x4 g2[4], b2[4];
#pragma unroll
        for (int j = 0; j < 4; ++j) { g2[j] = *(const f32x4*)(p.ln2_g + 256 * j + 4 * lane); b2[j] = *(const f32x4*)(p.ln2_b + 256 * j + 4 * lane); }
        f32x4 g1[4], b1[4];
#pragma unroll
        for (int j = 0; j < 4; ++j) { g1[j] = *(const f32x4*)(p.ln1_g + 256 * j + 4 * lane); b1[j] = *(const f32x4*)(p.ln1_b + 256 * j + 4 * lane); }
        for (int m0 = gw; m0 < M; m0 += 2 * NGW) {
            float gk[2][4]; int dk[2][4]; f32x4 v[2][4]; float s[2];
            f32x2 ms[2];
#pragma unroll
            for (int r2 = 0; r2 < 2; ++r2) { const int m = m0 + r2 * NGW;
#pragma unroll
                for (int k = 0; k < 4; ++k) { gk[r2][k] = TOKG[m * 4 + k]; dk[r2][k] = TOKD[m * 4 + k]; }
                ms[r2] = *(const f32x2*)((const float*)(ws + WS_MS) + (size_t)m * 2); }
#pragma unroll
            for (int r2 = 0; r2 < 2; ++r2) { const int m = m0 + r2 * NGW; s[r2] = 0.f;
#pragma unroll
                for (int j = 0; j < 4; ++j) {
                    f32x4 a = ((*(const f32x4*)(p.out + (size_t)m * D + 256 * j + 4 * lane) - ms[r2].x) * ms[r2].y * g1[j] + b1[j]) * DN_ALPHA;
#pragma unroll
                    for (int k = 0; k < 4; ++k) { const u32x2 y = *(const u32x2*)(YB + (size_t)dk[r2][k] * D + 256 * j + 4 * lane);
                        a[0] += gk[r2][k] * bflo(y.x); a[1] += gk[r2][k] * bfhi(y.x); a[2] += gk[r2][k] * bflo(y.y); a[3] += gk[r2][k] * bfhi(y.y); }
                    v[r2][j] = a; s[r2] += (a[0] + a[1]) + (a[2] + a[3]); } }
#pragma unroll
            for (int r2 = 0; r2 < 2; ++r2) { const int m = m0 + r2 * NGW;
                const float mean = wave_sum(s[r2]) * (1.f / D); float s2 = 0.f;
#pragma unroll
                for (int j = 0; j < 4; ++j) { v[r2][j] = v[r2][j] - mean; s2 += (v[r2][j][0] * v[r2][j][0] + v[r2][j][1] * v[r2][j][1]) + (v[r2][j][2] * v[r2][j][2] + v[r2][j][3] * v[r2][j][3]); }
                const float rstd = 1.f / sqrtf(wave_sum(s2) * (1.f / D) + LN_EPS);
#pragma unroll
                for (int j = 0; j < 4; ++j) { f32x4 o = v[r2][j] * rstd * g2[j] + b2[j];
                    if (bad) { const float q = __builtin_nanf(""); o = (f32x4){q, q, q, q}; }
                    *(f32x4*)(outp + (size_t)m * D + 256 * j + 4 * lane) = o; } }
        } }
    }
#undef IN
#undef SEAM
}

#ifndef MK_NLAUNCH
#define MK_NLAUNCH 1
#endif
constexpr int NPHASE = 15;
extern "C" void kernel_launch(void* const* d_in, const int* in_sizes, int n_in, void* d_out, int out_size, void* d_ws, size_t ws_size, hipStream_t stream) {
    static int grid = 0;
    if (grid == 0) {
        if (n_in != 29 || in_sizes[0] != M * D || out_size != M * D || ws_size < WS_NEED) { fprintf(stderr, "kernel_launch: unexpected shapes (n_in %d, in0 %d, out %d, ws %zu)\n", n_in, n_in > 0 ? in_sizes[0] : -1, out_size, ws_size); grid = -1; return; }
        int dev = 0, cus = 0, per_cu = 0;
        if (hipGetDevice(&dev) != hipSuccess || hipDeviceGetAttribute(&cus, hipDeviceAttributeMultiprocessorCount, dev) != hipSuccess) { grid = -1; return; }
        if (hipFuncSetAttribute((const void*)mk_fwd, hipFuncAttributeMaxDynamicSharedMemorySize, LDS_BYTES) != hipSuccess) { fprintf(stderr, "kernel_launch: hipFuncSetAttribute failed\n"); grid = -1; return; }
        if (hipOccupancyMaxActiveBlocksPerMultiprocessor(&per_cu, (const void*)mk_fwd, NWAVES * 64, LDS_BYTES) != hipSuccess || per_cu < 1) fprintf(stderr, "kernel_launch: occupancy query reports %d\n", per_cu);
        (void)hipGetLastError();
        grid = cus;
    }
    if (grid < 0) return;
    (void)hipMemsetAsync((char*)d_ws + WS_CTL, 0, CTL_ZERO_BYTES, stream);
    Params p{};
    const float** f = (const float**)&p;
    for (int i = 0; i < 29; ++i) f[i] = (const float*)d_in[i];
    p.out = (float*)d_out; p.ws = (unsigned char*)d_ws;
#if MK_NLAUNCH == 1
    p.ph_lo = 0; p.ph_hi = NPHASE;
    hipLaunchKernelGGL(mk_fwd, dim3(grid), dim3(NWAVES * 64), LDS_BYTES, stream, p);
#else
    for (int k = 0; k < NPHASE; ++k) { p.ph_lo = k; p.ph_hi = k + 1; hipLaunchKernelGGL(mk_fwd, dim3(grid), dim3(NWAVES * 64), LDS_BYTES, stream, p); }
#endif
}
```

```cpp
#include <hip/hip_runtime.h>
#include <cstdio>
#include <cstdint>

#define GAS __attribute__((address_space(1)))
#define LAS __attribute__((address_space(3)))
typedef unsigned short bf16_t;
typedef short bf16x8 __attribute__((ext_vector_type(8)));
typedef short s16x4 __attribute__((ext_vector_type(4)));
typedef float f32x2 __attribute__((ext_vector_type(2)));
typedef float f32x4 __attribute__((ext_vector_type(4)));
typedef float f32x8 __attribute__((ext_vector_type(8)));
typedef float f32x16 __attribute__((ext_vector_type(16)));
typedef unsigned u32x2 __attribute__((ext_vector_type(2)));
typedef unsigned u32x4 __attribute__((ext_vector_type(4)));

constexpr int M = 16384, D = 1024, SEQ = 8192, NE = 32, TOPK = 4, DFF = 1024;
constexpr float DN_ALPHA = 1.189207115002721f;
constexpr float LN_EPS = 1e-5f;
constexpr float LAM_INIT = 0.2f;
constexpr int NIN = 8224;

typedef __bf16 bf16x2_t __attribute__((ext_vector_type(2)));
__device__ __forceinline__ unsigned cvt_pk_bf16(float lo, float hi) { f32x2 v = {lo, hi}; bf16x2_t b = __builtin_convertvector(v, bf16x2_t); return __builtin_bit_cast(unsigned, b); }
__device__ __forceinline__ float bf2f(unsigned short b) { return __uint_as_float(((unsigned)b) << 16); }
__device__ __forceinline__ float bflo(unsigned w) { return __uint_as_float(w << 16); }
__device__ __forceinline__ float bfhi(unsigned w) { return __uint_as_float(w & 0xffff0000u); }
__device__ __forceinline__ float fast_exp(float x) { return __builtin_amdgcn_exp2f(x * 1.4426950408889634f); }
__device__ __forceinline__ float fast_sigmoid(float x) { return __builtin_amdgcn_rcpf(1.0f + fast_exp(-x)); }

namespace pg8 {
constexpr int BM = 256, BK = 64, HALF = 128, HTB = HALF * BK * 2, STAGE_BYTES = 8 * HTB, NXCD = 8, WGM = 8;
__host__ __device__ __forceinline__ int lds_byte(int r, int c) { const int st = (r >> 4) * 2 + (c >> 5), rr = r & 15, cc = c & 31, ob = rr * 64 + cc * 2; return st * 1024 + (ob ^ (((ob >> 9) & 1) << 5)); }
__host__ __device__ __forceinline__ void stage_rc(int b, int& R, int& C) { const int st = b / 1024, sb = b % 1024, swz = sb ^ (((sb >> 9) & 1) << 5); R = (st >> 1) * 16 + swz / 64; C = (st & 1) * 32 + (swz % 64) / 2; }
__host__ __device__ __forceinline__ int perm32(int rho) { const int n = rho >> 4, i = rho & 15; return 8 * (i >> 2) + 4 * n + (i & 3); }

struct Unit { int pm, pn, bt, e; const bf16_t* A; const bf16_t* Bt; };
struct Gemm { const bf16_t* A; const bf16_t* Bt; int M, N, K; };

struct StaticOrder {
    static constexpr bool GATHER = false; __device__ __forceinline__ unsigned row_off(const Unit&, int) const { return 0u; }
    int nM, nN, nwg, G, c;
    __device__ __forceinline__ void init(int M_, int N_, int G_, int c_) { nM = M_ / BM; nN = N_ / BM; nwg = nM * nN; G = G_; c = c_; }
    __device__ __forceinline__ bool next(int i, Unit& u) const {
        const long L = (long)i * G + c; if (L >= nwg) return false;
        int wgid = (int)L; { const int q = nwg / NXCD, r = nwg % NXCD, xcd = wgid % NXCD, off = wgid / NXCD; wgid = (xcd < r ? xcd * (q + 1) : r * (q + 1) + (xcd - r) * q) + off; }
        const int nig = WGM * nN, gid = wgid / nig, fm = gid * WGM, gsz = (nM - fm) < WGM ? (nM - fm) : WGM;
        u.pm = fm + ((wgid % nig) % gsz); u.pn = (wgid % nig) / gsz; u.bt = u.pn; u.e = 0; u.A = nullptr; u.Bt = nullptr; return true;
    }
    __device__ __forceinline__ void a_ready(const Unit&) const {}
    __device__ __forceinline__ void done(const Unit&) const {}
};
struct InProjOrder {
    static constexpr bool GATHER = false; __device__ __forceinline__ unsigned row_off(const Unit&, int) const { return 0u; }
    StaticOrder S0; int c; bool fast;
    __device__ __forceinline__ bool next(int i, Unit& u) const {
        if (!fast) return S0.next(i, u);
        if (i >= 6) return false;
        u.pm = 8 * (c >> 5) + (c & 7); u.pn = ((c >> 3) & 3) + 4 * i; u.bt = u.pn; u.e = 0; u.A = nullptr; u.Bt = nullptr; return true;
    }
    __device__ __forceinline__ void a_ready(const Unit&) const {}
    __device__ __forceinline__ void done(const Unit&) const {}
};
struct MoeOrder {
    static constexpr bool GATHER = false; __device__ __forceinline__ unsigned row_off(const Unit&, int) const { return 0u; }
    int ntiles, nN, G, c; const LAS int* tile_e; long first;
    int mix;
    __device__ __forceinline__ bool next(int i, Unit& u) const {
        long L;
        if (mix >= 0) { const long y = (long)i * G + c; if (y >= (long)mix + (long)ntiles * nN - 256) return false;
            if (y < mix) { const int yy = (int)y; u.pm = 32 * ((yy >> 4) & 1) + 4 * (yy >> 5) + ((yy >> 2) & 3); u.pn = yy & 3; u.e = tile_e[u.pm]; u.bt = u.e * nN + u.pn; u.A = nullptr; u.Bt = nullptr; return true; }
            L = 256 + (y - mix); }
        else { L = first + (long)i * G + c; if (L >= (long)ntiles * nN) return false; }
        u.pm = (int)(L / nN); u.pn = (int)(L % nN); u.e = tile_e[u.pm]; u.bt = u.e * nN + u.pn; u.A = nullptr; u.Bt = nullptr; return true;
    }
    __device__ __forceinline__ void a_ready(const Unit&) const {}
    __device__ __forceinline__ void done(const Unit&) const {}
};

constexpr int Y_SPLIT_TILE = 277; constexpr size_t Y_DELTA = (((size_t)320 << 20) - ((size_t)5 << 20) - (size_t)Y_SPLIT_TILE * 256 * 2048) / 2;
constexpr int H1B_SPLIT = 13824; constexpr unsigned H1B_LO = 293u << 20, H1B_HI = 144u << 20;
__device__ __forceinline__ unsigned h1b_off(int row) { return row < H1B_SPLIT ? H1B_LO + (unsigned)row * 2048u : H1B_HI + (unsigned)(row - H1B_SPLIT) * 2048u; }
struct MoeGatherOrder {
    static constexpr bool GATHER = true;
    int ntiles, nN, G, c; const LAS int* tile_e; const unsigned short* src; long lim;
    const LAS int* off; const LAS int* cnt;
    unsigned* post;
    __device__ __forceinline__ bool next(int i, Unit& u) const {
        const long L = (long)i * G + c; if (L >= lim) return false;
        u.pm = (int)(L / nN); u.pn = (int)(L % nN); u.e = tile_e[u.pm]; u.bt = u.e * nN + u.pn; u.A = nullptr; u.Bt = nullptr; return true;
    }
    __device__ __forceinline__ unsigned row_off(const Unit& u, int r) const { const int e = u.e, idx = u.pm * BM + r - off[e]; int tok = 0; if (idx < cnt[e]) tok = src[e * M + idx]; return h1b_off(tok); }
    __device__ __forceinline__ void a_ready(const Unit&) const {}
    __device__ __forceinline__ void done(const Unit& u) const {
        if (post != nullptr && ((long)u.pm * nN + u.pn) / G == 1) {
            asm volatile("s_waitcnt vmcnt(0)" ::: "memory"); __syncthreads();
            if (threadIdx.x == 0) __hip_atomic_fetch_add(post, 1u, __ATOMIC_RELAXED, __HIP_MEMORY_SCOPE_AGENT); }
    }
};

struct MoeMixOrder {
    static constexpr bool GATHER = true;
    int c, l12, f13; long base12; const LAS int* tile_e; const unsigned short* src; unsigned act_off; const unsigned char* ws; long b_wgu, b_wd; const LAS int* off; const LAS int* cnt;
    bool loc;
    __device__ __forceinline__ bool next(int i, Unit& u) const {
        if (i > 0 || c >= l12 + f13) return false;
        const int st = c >= l12 ? 1 : 0; const long x = st ? (long)(c - l12) : base12 + c; const int sh = 3 - st;
        u.pm = (int)(x >> sh); u.pn = (int)(x & ((1 << sh) - 1));
        if (st && loc) { const int j = c & 31; u.pm = 32 * (j >> 4) + 4 * (c >> 5) + ((j >> 2) & 3); u.pn = j & 3; }
        const int e = tile_e[u.pm]; u.e = e | (st << 8); u.bt = (e << sh) + u.pn;
        u.A = (const bf16_t*)ws; u.Bt = (const bf16_t*)(ws + b_wgu + (long)st * (b_wd - b_wgu)); return true;
    }
    __device__ __forceinline__ unsigned row_off(const Unit& u, int rr) const { const int row = u.pm * BM + rr; if (u.e & 256) return act_off + (unsigned)row * 2048u;
        const int e = u.e, idx = row - off[e]; int tok = 0; if (idx < cnt[e]) tok = src[e * M + idx]; return h1b_off(tok); }
    __device__ __forceinline__ void a_ready(const Unit&) const {}
    __device__ __forceinline__ void done(const Unit&) const {}
};

#define PG8_FOR_AI_M _Pragma("unroll") for (int ai = 0; ai < 2; ++ai) _Pragma("unroll") for (int m = 0; m < 4; ++m)
__device__ __forceinline__ u32x4 pack8(const f32x4 v0, const f32x4 v1) { u32x4 w; w.x = cvt_pk_bf16(v0[0], v0[1]); w.y = cvt_pk_bf16(v0[2], v0[3]); w.z = cvt_pk_bf16(v1[0], v1[1]); w.w = cvt_pk_bf16(v1[2], v1[3]); return w; }

__device__ __forceinline__ int vt_col(int t) { return (t & ~12) | ((t & 4) << 1) | ((t & 8) >> 1); }
struct EpiIn {
    static constexpr bool PERM = true, AFTER_DRAIN = false;
    bf16_t *qkg, *vg, *rg, *qd, *kd, *vd; const float* rope;
    __device__ __forceinline__ void operator()(const f32x4 (&acc)[2][2][4][2], const Unit& u, int wr, int wc, int fr, int fq) const {
        const int grp = u.pn >> 2, ct = u.pn & 3;
        bf16_t* base = grp == 0 ? qkg : grp == 1 ? vg : grp == 2 ? rg : grp == 3 ? qd : grp == 4 ? kd : vd;
        const int row0 = u.pm * BM + wr * 64 + fr, col0 = ct * BM + wc * 32 + 8 * fq;
        const float sc = (grp == 0 && ct < 2) ? 0.08838834764831845f : (grp == 3 ? 0.18033688011112042f : 1.0f);
        const bool rot = (grp == 3 || grp == 4) && ((wc & 1) == 0);
        PG8_FOR_AI_M {
            const int row = row0 + ai * HALF + m * 16;
            f32x4 cs0, cs1, sn0, sn1;
            if (rot) { const float* rp = rope + (size_t)(row & (SEQ - 1)) * 8; cs0 = *(const f32x4*)rp; cs1 = *(const f32x4*)(rp + 4); sn0 = *(const f32x4*)(rp + SEQ * 8); sn1 = *(const f32x4*)(rp + SEQ * 8 + 4); }
#pragma unroll
            for (int bj = 0; bj < 2; ++bj) {
                f32x4 v0 = acc[ai][bj][m][0], v1 = acc[ai][bj][m][1];
                if (rot) {
                    f32x4 o0, o1;
#pragma unroll
                    for (int j = 0; j < 4; ++j) { o0[j] = __shfl_xor(v0[j], 16); o1[j] = __shfl_xor(v1[j], 16); }
                    if (fq == 0) { v0 = v0 * cs0 - o0 * sn0; v1 = v1 * cs1 - o1 * sn1; }
                    else if (fq == 1) { v0 = v0 * cs0 + o0 * sn0; v1 = v1 * cs1 + o1 * sn1; }
                }
                if (grp == 2) {
#pragma unroll
                    for (int j = 0; j < 4; ++j) { v0[j] = v0[j] * fast_sigmoid(v0[j]); v1[j] = v1[j] * fast_sigmoid(v1[j]); }
                }
                v0 = v0 * sc; v1 = v1 * sc;
                if (grp == 5) {
                    const int c0 = col0 + bj * HALF; bf16_t* vtp = base + ((size_t)((row >> 13) * 8 + (c0 >> 7)) * 128 + (c0 & 127)) * SEQ + vt_col(row & (SEQ - 1));
                    const u32x4 w = pack8(v0, v1);
                    vtp[0] = (bf16_t)(w.x & 0xffffu); vtp[SEQ] = (bf16_t)(w.x >> 16); vtp[2 * SEQ] = (bf16_t)(w.y & 0xffffu); vtp[3 * SEQ] = (bf16_t)(w.y >> 16);
                    vtp[4 * SEQ] = (bf16_t)(w.z & 0xffffu); vtp[5 * SEQ] = (bf16_t)(w.z >> 16); vtp[6 * SEQ] = (bf16_t)(w.w & 0xffffu); vtp[7 * SEQ] = (bf16_t)(w.w >> 16);
                } else
                *(u32x4*)(base + (size_t)row * D + col0 + bj * HALF) = pack8(v0, v1);
            }
        }
    }
};
struct EpiSig {
    static constexpr bool PERM = true, AFTER_DRAIN = false;
    bf16_t *sgg, *sgd;
    __device__ __forceinline__ void operator()(const f32x4 (&acc)[2][2][4][2], const Unit& u, int wr, int wc, int fr, int fq) const {
        bf16_t* base = (u.pn < 4) ? sgg : sgd; const int ct = u.pn & 3;
        const int row0 = u.pm * BM + wr * 64 + fr, col0 = ct * BM + wc * 32 + 8 * fq;
        PG8_FOR_AI_M {
            const int row = row0 + ai * HALF + m * 16;
#pragma unroll
            for (int bj = 0; bj < 2; ++bj) {
                f32x4 v0 = acc[ai][bj][m][0], v1 = acc[ai][bj][m][1];
#pragma unroll
                for (int j = 0; j < 4; ++j) { v0[j] = fast_sigmoid(v0[j]); v1[j] = fast_sigmoid(v1[j]); }
                *(u32x4*)(base + (size_t)row * D + col0 + bj * HALF) = pack8(v0, v1);
            }
        }
    }
};
struct EpiMulF32 {
    static constexpr bool PERM = false, AFTER_DRAIN = false;
    const bf16_t* gate; float* out;
    __device__ __forceinline__ void operator()(const f32x4 (&acc)[2][2][4][2], const Unit& u, int wr, int wc, int fr, int fq) const {
        const int row0 = u.pm * BM + wr * 64 + fr, col0 = u.pn * BM + wc * 32 + 4 * fq;
        PG8_FOR_AI_M {
            const size_t off = (size_t)(row0 + ai * HALF + m * 16) * D + col0;
#pragma unroll
            for (int bj = 0; bj < 2; ++bj)
#pragma unroll
                for (int n = 0; n < 2; ++n) {
                    const u32x2 g = *(const u32x2*)(gate + off + bj * HALF + n * 16);
                    const f32x4 a = acc[ai][bj][m][n];
                    f32x4 o; o[0] = bflo(g.x) * a[0]; o[1] = bfhi(g.x) * a[1]; o[2] = bflo(g.y) * a[2]; o[3] = bfhi(g.y) * a[3];
                    *(f32x4*)(out + off + bj * HALF + n * 16) = o;
                }
        }
    }
};
struct EpiAddMulBf16 {
    static constexpr bool PERM = true, AFTER_DRAIN = false;
    const bf16_t* gate; const float* part; bf16_t* out;
    __device__ __forceinline__ void operator()(const f32x4 (&acc)[2][2][4][2], const Unit& u, int wr, int wc, int fr, int fq) const {
        const int row0 = u.pm * BM + wr * 64 + fr, col0 = u.pn * BM + wc * 32 + 8 * fq;
        PG8_FOR_AI_M {
            const size_t off = (size_t)(row0 + ai * HALF + m * 16) * D + col0;
#pragma unroll
            for (int bj = 0; bj < 2; ++bj) {
                const u32x4 g = *(const u32x4*)(gate + off + bj * HALF);
                const f32x4 p0 = *(const f32x4*)(part + off + bj * HALF), p1 = *(const f32x4*)(part + off + bj * HALF + 4);
                const f32x4 a0 = acc[ai][bj][m][0], a1 = acc[ai][bj][m][1];
                f32x4 v0, v1;
                v0[0] = p0[0] + bflo(g.x) * a0[0]; v0[1] = p0[1] + bfhi(g.x) * a0[1]; v0[2] = p0[2] + bflo(g.y) * a0[2]; v0[3] = p0[3] + bfhi(g.y) * a0[3];
                v1[0] = p1[0] + bflo(g.z) * a1[0]; v1[1] = p1[1] + bfhi(g.z) * a1[1]; v1[2] = p1[2] + bflo(g.w) * a1[2]; v1[3] = p1[3] + bfhi(g.w) * a1[3];
                *(u32x4*)(out + off + bj * HALF) = pack8(v0, v1);
            }
        }
    }
};
struct EpiResid {
    static constexpr bool PERM = false, AFTER_DRAIN = false;
    const bf16_t* res; float* out;
    __device__ __forceinline__ void operator()(const f32x4 (&acc)[2][2][4][2], const Unit& u, int wr, int wc, int fr, int fq) const {
        const int row0 = u.pm * BM + wr * 64 + fr, col0 = u.pn * BM + wc * 32 + 4 * fq;
        PG8_FOR_AI_M {
            const size_t off = (size_t)(row0 + ai * HALF + m * 16) * D + col0;
#pragma unroll
            for (int bj = 0; bj < 2; ++bj)
#pragma unroll
                for (int n = 0; n < 2; ++n) {
                    const u32x2 g = *(const u32x2*)(res + off + bj * HALF + n * 16);
                    const f32x4 a = acc[ai][bj][m][n];
                    f32x4 o; o[0] = DN_ALPHA * bflo(g.x) + a[0]; o[1] = DN_ALPHA * bfhi(g.x) + a[1]; o[2] = DN_ALPHA * bflo(g.y) + a[2]; o[3] = DN_ALPHA * bfhi(g.y) + a[3];
                    *(f32x4*)(out + off + bj * HALF + n * 16) = o;
                }
        }
    }
};
struct ChainOrder {
    static constexpr bool GATHER = false; __device__ __forceinline__ unsigned row_off(const Unit&, int) const { return 0u; }
    StaticOrder S0; const unsigned char* ws; long a_h0, a_of, a_o1, b_gate, b_bra, b_brb;
    __device__ __forceinline__ bool next(int i, Unit& u) const {
        if (!S0.next(i >> 2, u)) return false;
        const long st = i & 3, odd = st & 1, hi = st >> 1; u.e = (int)st; u.bt = u.pn;
        const long offA = a_h0 + odd * ((a_of - a_h0) + hi * (a_o1 - a_of));
        const long offB = odd * (b_bra + hi * (b_brb - b_bra)) + (1 - odd) * (b_gate + hi * (1024L * 1024L * 2L));
        u.A = (const bf16_t*)(ws + offA); u.Bt = (const bf16_t*)(ws + offB); return true;
    }
    __device__ __forceinline__ void a_ready(const Unit&) const {}
    __device__ __forceinline__ void done(const Unit&) const {}
};
struct EpiChain {
    static constexpr bool PERM = true, AFTER_DRAIN = false;
    bf16_t* sgg; bf16_t* sgd; float* part; bf16_t* mixed;
    __device__ __forceinline__ void operator()(const f32x4 (&acc)[2][2][4][2], const Unit& u, int wr, int wc, int fr, int fq) const {
        const int row0 = u.pm * BM + wr * 64 + fr, col0 = u.pn * BM + wc * 32 + 8 * fq;
        if (u.e == 0 || u.e == 2) {
            bf16_t* base = u.e == 0 ? sgg : sgd;
            PG8_FOR_AI_M {
                const size_t off = (size_t)(row0 + ai * HALF + m * 16) * D + col0;
#pragma unroll
                for (int bj = 0; bj < 2; ++bj) {
                    f32x4 v0 = acc[ai][bj][m][0], v1 = acc[ai][bj][m][1];
#pragma unroll
                    for (int j = 0; j < 4; ++j) { v0[j] = fast_sigmoid(v0[j]); v1[j] = fast_sigmoid(v1[j]); }
                    *(u32x4*)(base + off + bj * HALF) = pack8(v0, v1);
                }
            }
        } else {
            const bf16_t* gate = u.e == 1 ? sgg : sgd;
            PG8_FOR_AI_M {
                const size_t off = (size_t)(row0 + ai * HALF + m * 16) * D + col0;
#pragma unroll
                for (int bj = 0; bj < 2; ++bj) {
                    const u32x4 g = *(const u32x4*)(gate + off + bj * HALF);
                    const f32x4 a0 = acc[ai][bj][m][0], a1 = acc[ai][bj][m][1];
                    f32x4 v0, v1;
                    v0[0] = bflo(g.x) * a0[0]; v0[1] = bfhi(g.x) * a0[1]; v0[2] = bflo(g.y) * a0[2]; v0[3] = bfhi(g.y) * a0[3];
                    v1[0] = bflo(g.z) * a1[0]; v1[1] = bfhi(g.z) * a1[1]; v1[2] = bflo(g.w) * a1[2]; v1[3] = bfhi(g.w) * a1[3];
                    if (u.e == 1) { *(f32x4*)(part + off + bj * HALF) = v0; *(f32x4*)(part + off + bj * HALF + 4) = v1; }
                    else { const f32x4 p0 = *(const f32x4*)(part + off + bj * HALF), p1 = *(const f32x4*)(part + off + bj * HALF + 4);
                        *(u32x4*)(mixed + off + bj * HALF) = pack8(p0 + v0, p1 + v1); }
                }
                asm volatile("" ::: "memory");
            }
        }
    }
};
struct EpiSwiglu {
    static constexpr bool PERM = true, AFTER_DRAIN = false;
    const float* bgate; const float* bup; bf16_t* out;
    __device__ __forceinline__ void operator()(const f32x4 (&acc)[2][2][4][2], const Unit& u, int wr, int wc, int fr, int fq) const {
        const int row0 = u.pm * BM + wr * 64 + fr, col0 = u.pn * HALF + wc * 32 + 8 * fq;
        const float* bg = bgate + (size_t)u.e * DFF + col0; const float* bu = bup + (size_t)u.e * DFF + col0;
        const f32x4 bg0 = *(const f32x4*)bg, bg1 = *(const f32x4*)(bg + 4), bu0 = *(const f32x4*)bu, bu1 = *(const f32x4*)(bu + 4);
        PG8_FOR_AI_M {
            const size_t off = (size_t)(row0 + ai * HALF + m * 16) * DFF + col0;
            f32x4 r0, r1;
#pragma unroll
            for (int j = 0; j < 4; ++j) {
                float g = fminf(acc[ai][0][m][0][j] + bg0[j], 7.0f), up = fminf(fmaxf(acc[ai][1][m][0][j] + bu0[j], -7.0f), 7.0f);
                r0[j] = g * fast_sigmoid(1.702f * g) * (up + 1.0f);
                g = fminf(acc[ai][0][m][1][j] + bg1[j], 7.0f); up = fminf(fmaxf(acc[ai][1][m][1][j] + bu1[j], -7.0f), 7.0f);
                r1[j] = g * fast_sigmoid(1.702f * g) * (up + 1.0f);
            }
            *(u32x4*)(out + off) = pack8(r0, r1);
        }
    }
};
struct EpiBiasBf16 {
    static constexpr bool PERM = true, AFTER_DRAIN = false;
    const float* bias; bf16_t* out;
    __device__ __forceinline__ void operator()(const f32x4 (&acc)[2][2][4][2], const Unit& u, int wr, int wc, int fr, int fq) const {
        const int row0 = u.pm * BM + wr * 64 + fr, col0 = u.pn * BM + wc * 32 + 8 * fq;
        const float* bp = bias + (size_t)u.e * D + col0;
        f32x4 bv[2][2];
#pragma unroll
        for (int bj = 0; bj < 2; ++bj) { bv[bj][0] = *(const f32x4*)(bp + bj * HALF); bv[bj][1] = *(const f32x4*)(bp + bj * HALF + 4); }
        bf16_t* const o2 = out + (u.pm >= Y_SPLIT_TILE ? Y_DELTA : (size_t)0);
        PG8_FOR_AI_M {
            const size_t off = (size_t)(row0 + ai * HALF + m * 16) * D + col0;
#pragma unroll
            for (int bj = 0; bj < 2; ++bj) *(u32x4*)(o2 + off + bj * HALF) = pack8(acc[ai][bj][m][0] + bv[bj][0], acc[ai][bj][m][1] + bv[bj][1]);
        }
    }
};
struct EpiMoe {
    static constexpr bool PERM = true, AFTER_DRAIN = false;
    EpiSwiglu a; EpiBiasBf16 b;
    __device__ __forceinline__ void operator()(const f32x4 (&acc)[2][2][4][2], const Unit& u, int wr, int wc, int fr, int fq) const {
        if (u.e & 256) { Unit v = u; v.e = u.e & 255; b(acc, v, wr, wc, fr, fq); } else a(acc, u, wr, wc, fr, fq);
    }
};

template <class Epi, class Sched, bool ALIGN_EPI = false, bool SP2 = false>
__device__ __forceinline__ void gemm_phase(LAS unsigned char* lds, const Gemm g, const Sched& S, const Epi& E) {
    const int tid = threadIdx.x, wid = __builtin_amdgcn_readfirstlane(tid >> 6), lane = tid & 63, wr = wid >> 2, wc = wid & 3, fr = lane & 15, fq = lane >> 4;
    const int K = g.K, nt = K / BK;
    unsigned voffA[2], voffB[2];
#pragma unroll
    for (int i = 0; i < 2; ++i) { int R, C; stage_rc(tid * 16 + i * 8192, R, C); const int Rb = Epi::PERM ? ((R & ~31) + perm32(R & 31)) : R;
        voffA[i] = (unsigned)(R * K + C) * 2u; voffB[i] = (unsigned)(Rb * K + C) * 2u; }
    unsigned vgc[2][2] = {{0u, 0u}, {0u, 0u}}, vgn[2][2] = {{0u, 0u}, {0u, 0u}}, vgnn[2][2] = {{0u, 0u}, {0u, 0u}}; int gR[2], gC[2];
#pragma unroll
    for (int i = 0; i < 2; ++i) stage_rc(tid * 16 + i * 8192, gR[i], gC[i]);
#define PG8_GOFF(dst, u) do { _Pragma("unroll") for (int _h = 0; _h < 2; ++_h) _Pragma("unroll") for (int _i = 0; _i < 2; ++_i) \
        dst[_h][_i] = S.row_off(u, _h * HALF + gR[_i]) + (unsigned)(gC[_i] * 2); } while (0)
#define PG8_STAGE_G(bufoff, gbase, vg) do { _Pragma("unroll") for (int _i = 0; _i < 2; ++_i) \
        __builtin_amdgcn_global_load_lds((const unsigned*)((const char*)(gbase) + (vg)[_i]), (LAS unsigned*)(lds + (bufoff) + ldsw + _i * 8192), 16, 0, 0); } while (0)
#define PG8_STAGE_A(bufoff, gb, h, nx) do { if constexpr (Sched::GATHER) { unsigned _v[2]; _v[0] = (nx) ? vgn[h][0] : vgc[h][0]; _v[1] = (nx) ? vgn[h][1] : vgc[h][1]; PG8_STAGE_G(bufoff, gb, _v); } \
        else PG8_STAGE(bufoff, (gb) + (h) * hstep, voffA); } while (0)
    const size_t kstep = (size_t)(BK * 2);
    const size_t hstep = (size_t)HALF * K * 2;
    const size_t tstep = 2 * hstep;
    const unsigned ldsw = (unsigned)wid * 1024u;
    const int aoff = lds_byte(wr * 64 + fr, fq * 8), boff = lds_byte(wc * 32 + fr, fq * 8);
#define PG8_SA(b, h) (((b) * 2 + (h)) * HTB)
#define PG8_SB(b, h) ((4 + (b) * 2 + (h)) * HTB)
#define PG8_STAGE(bufoff, gbase, voff) do { _Pragma("unroll") for (int _i = 0; _i < 2; ++_i) \
        __builtin_amdgcn_global_load_lds((const unsigned*)((const char*)(gbase) + (voff)[_i]), (LAS unsigned*)(lds + (bufoff) + ldsw + _i * 8192), 16, 0, 0); } while (0)
#define PG8_LDA(dst, b, h) do { _Pragma("unroll") for (int m = 0; m < 4; ++m) _Pragma("unroll") for (int k = 0; k < 2; ++k) dst[m][k] = *(const LAS bf16x8*)(lds + PG8_SA(b, h) + aoff + m * 2048 + k * 1024); } while (0)
#define PG8_LDB(dst, b, h) do { _Pragma("unroll") for (int n = 0; n < 2; ++n) _Pragma("unroll") for (int k = 0; k < 2; ++k) dst[n][k] = *(const LAS bf16x8*)(lds + PG8_SB(b, h) + boff + n * 2048 + k * 1024); } while (0)
#define PG8_MMA(ai, bj, At, Bt) do { __builtin_amdgcn_s_setprio(1); _Pragma("unroll") for (int m = 0; m < 4; ++m) _Pragma("unroll") for (int n = 0; n < 2; ++n) _Pragma("unroll") for (int k = 0; k < 2; ++k) \
        acc[ai][bj][m][n] = __builtin_amdgcn_mfma_f32_16x16x32_bf16(Bt[n][k], At[m][k], acc[ai][bj][m][n], 0, 0, 0); __builtin_amdgcn_s_setprio(0); } while (0)
#define PG8_WAIT_V(n) asm volatile("s_waitcnt vmcnt(" #n ")" ::: "memory")
#define PG8_WAIT_L(n) asm volatile("s_waitcnt lgkmcnt(" #n ")" ::: "memory")
#define PG8_BAR __builtin_amdgcn_s_barrier()
#define PG8_SCHED __builtin_amdgcn_sched_barrier(0)
    Unit cur, nxt; int ui = 0;
    if (!S.next(0, cur)) return;
    f32x4 acc[2][2][4][2];
#pragma unroll
    for (int a = 0; a < 2; ++a)
#pragma unroll
        for (int b = 0; b < 2; ++b)
#pragma unroll
            for (int m = 0; m < 4; ++m)
#pragma unroll
                for (int n = 0; n < 2; ++n) acc[a][b][m][n] = (f32x4){0.f, 0.f, 0.f, 0.f};
    bf16x8 At[4][2], B0[2][2], B1[2][2];
    const char* cA = (const char*)(cur.A ? cur.A : g.A) + (Sched::GATHER ? (size_t)0 : (size_t)cur.pm * tstep); const char* cB = (const char*)(cur.Bt ? cur.Bt : g.Bt) + (size_t)cur.bt * tstep;
    S.a_ready(cur);
    if constexpr (Sched::GATHER) { PG8_GOFF(vgc, cur); Unit n1; if (S.next(1, n1)) PG8_GOFF(vgn, n1); }
    if constexpr (SP2) {
        PG8_STAGE(PG8_SB(0, 0), cB, voffB); PG8_STAGE(PG8_SB(0, 1), cB + hstep, voffB); PG8_STAGE_A(PG8_SA(0, 0), cA, 0, false); PG8_STAGE_A(PG8_SA(0, 1), cA, 1, false);
        if (wr == 1) PG8_BAR;
        PG8_WAIT_V(2); PG8_BAR;
        PG8_STAGE(PG8_SB(1, 0), cB + kstep, voffB); PG8_STAGE_A(PG8_SA(1, 0), cA + kstep, 0, false); PG8_STAGE(PG8_SB(1, 1), cB + hstep + kstep, voffB);
        PG8_WAIT_V(6); PG8_BAR;
    } else {
        PG8_STAGE(PG8_SB(0, 0), cB, voffB); PG8_STAGE(PG8_SA(0, 0), cA, voffA); PG8_STAGE(PG8_SB(0, 1), cB + hstep, voffB); PG8_STAGE(PG8_SA(0, 1), cA + hstep, voffA);
        if (wr == 1) PG8_BAR;
        PG8_WAIT_V(4); PG8_BAR;
        PG8_STAGE(PG8_SB(1, 0), cB + kstep, voffB); PG8_STAGE(PG8_SA(1, 0), cA + kstep, voffA); PG8_STAGE(PG8_SB(1, 1), cB + hstep + kstep, voffB);
        PG8_WAIT_V(6); PG8_BAR;
    }
    for (;;) {
        const bool has_next = S.next(ui + 1, nxt);
        const char* nA = has_next ? (const char*)(nxt.A ? nxt.A : g.A) + (Sched::GATHER ? (size_t)0 : (size_t)nxt.pm * tstep) : cA;
        if constexpr (Sched::GATHER) { Unit n2; if (S.next(ui + 2, n2)) PG8_GOFF(vgnn, n2); if (!has_next) { vgn[0][0] = vgc[0][0]; vgn[0][1] = vgc[0][1]; vgn[1][0] = vgc[1][0]; vgn[1][1] = vgc[1][1]; } } const char* nB = has_next ? (const char*)(nxt.Bt ? nxt.Bt : g.Bt) + (size_t)nxt.bt * tstep : cB;
        for (int t = 0; t < nt; t += 2) {
            const bool last = (t == nt - 2);
            const char* a1 = cA + (size_t)(t + 1) * kstep;
            const char* a2 = last ? nA : cA + (size_t)(t + 2) * kstep; const char* b2 = last ? nB : cB + (size_t)(t + 2) * kstep;
            const char* a3 = a2 + kstep; const char* b3 = b2 + kstep;
            if (last && has_next) S.a_ready(nxt);
            if constexpr (SP2) {
            PG8_LDB(B0, 0, 0); PG8_LDB(B1, 0, 1); PG8_SCHED; PG8_LDA(At, 0, 0); PG8_STAGE_A(PG8_SA(1, 1), a1, 1, false);
            PG8_WAIT_V(8); PG8_WAIT_L(0); PG8_BAR; PG8_MMA(0, 0, At, B0); PG8_MMA(0, 1, At, B1); PG8_BAR; PG8_SCHED;
            PG8_LDA(At, 0, 1); PG8_STAGE(PG8_SB(0, 0), b2, voffB); PG8_STAGE(PG8_SB(0, 1), b2 + hstep, voffB); PG8_STAGE_A(PG8_SA(0, 0), a2, 0, last);
            PG8_WAIT_V(8); PG8_WAIT_L(0); PG8_BAR; PG8_MMA(1, 0, At, B0); PG8_MMA(1, 1, At, B1); PG8_BAR; PG8_SCHED;
            PG8_LDB(B0, 1, 0); PG8_LDB(B1, 1, 1); PG8_SCHED; PG8_LDA(At, 1, 0); PG8_STAGE_A(PG8_SA(0, 1), a2, 1, last);
            PG8_WAIT_V(8); PG8_WAIT_L(0); PG8_BAR; PG8_MMA(0, 0, At, B0); PG8_MMA(0, 1, At, B1); PG8_BAR; PG8_SCHED;
            PG8_LDA(At, 1, 1); PG8_STAGE(PG8_SB(1, 0), b3, voffB); PG8_STAGE(PG8_SB(1, 1), b3 + hstep, voffB); PG8_STAGE_A(PG8_SA(1, 0), a3, 0, last);
            PG8_WAIT_V(8); PG8_WAIT_L(0); PG8_BAR; PG8_MMA(1, 0, At, B0); PG8_MMA(1, 1, At, B1); PG8_BAR; PG8_SCHED;
            } else {
            PG8_LDB(B0, 0, 0); PG8_SCHED; PG8_LDA(At, 0, 0); PG8_STAGE(PG8_SA(1, 1), a1 + hstep, voffA);
            PG8_WAIT_L(8); PG8_BAR; PG8_WAIT_L(0); PG8_MMA(0, 0, At, B0); PG8_BAR; PG8_SCHED;
            PG8_LDB(B1, 0, 1); PG8_STAGE(PG8_SB(0, 0), b2, voffB);
            PG8_BAR; PG8_WAIT_L(0); PG8_MMA(0, 1, At, B1); PG8_BAR;
            PG8_LDA(At, 0, 1); PG8_STAGE(PG8_SA(0, 0), a2, voffA);
            PG8_BAR; PG8_WAIT_L(0); PG8_MMA(1, 0, At, B0); PG8_BAR; PG8_SCHED;
            PG8_STAGE(PG8_SB(0, 1), b2 + hstep, voffB);
            PG8_WAIT_V(6); PG8_BAR; PG8_MMA(1, 1, At, B1); PG8_BAR;
            PG8_LDB(B0, 1, 0); PG8_SCHED; PG8_LDA(At, 1, 0); PG8_STAGE(PG8_SA(0, 1), a2 + hstep, voffA);
            PG8_WAIT_L(8); PG8_BAR; PG8_WAIT_L(0); PG8_MMA(0, 0, At, B0); PG8_BAR; PG8_SCHED;
            PG8_LDB(B1, 1, 1); PG8_STAGE(PG8_SB(1, 0), b3, voffB);
            PG8_BAR; PG8_WAIT_L(0); PG8_MMA(0, 1, At, B1); PG8_BAR;
            PG8_LDA(At, 1, 1); PG8_STAGE(PG8_SA(1, 0), a3, voffA);
            PG8_BAR; PG8_WAIT_L(0); PG8_MMA(1, 0, At, B0); PG8_BAR; PG8_SCHED;
            PG8_STAGE(PG8_SB(1, 1), b3 + hstep, voffB);
            PG8_WAIT_V(6); PG8_BAR; PG8_MMA(1, 1, At, B1); PG8_BAR;
            }
        }
        if constexpr (ALIGN_EPI) { if (wr == 0) PG8_BAR; }
        if constexpr (!Epi::AFTER_DRAIN) { E(acc, cur, wr, wc, fr, fq); S.done(cur); }
        if (!has_next) break;
#pragma unroll
        for (int a = 0; a < 2; ++a)
#pragma unroll
            for (int b = 0; b < 2; ++b)
#pragma unroll
                for (int m = 0; m < 4; ++m)
#pragma unroll
                    for (int n = 0; n < 2; ++n) acc[a][b][m][n] = (f32x4){0.f, 0.f, 0.f, 0.f};
        cur = nxt; cA = nA; cB = nB; ++ui;
        if constexpr (Sched::GATHER) { vgc[0][0] = vgn[0][0]; vgc[0][1] = vgn[0][1]; vgc[1][0] = vgn[1][0]; vgc[1][1] = vgn[1][1]; vgn[0][0] = vgnn[0][0]; vgn[0][1] = vgnn[0][1]; vgn[1][0] = vgnn[1][0]; vgn[1][1] = vgnn[1][1]; }
        if constexpr (ALIGN_EPI) { if (wr == 1) PG8_BAR; }
    }
    PG8_WAIT_V(0);
    if constexpr (!ALIGN_EPI) { if (wr == 0) PG8_BAR; }
    PG8_BAR;
    if constexpr (Epi::AFTER_DRAIN) { E.fused(acc, cur, wr, wc, fr, fq, lds, wid, lane); S.done(cur); }
#undef PG8_SA
#undef PG8_SB
#undef PG8_STAGE
#undef PG8_STAGE_A
#undef PG8_STAGE_G
#undef PG8_GOFF
#undef PG8_LDA
#undef PG8_LDB
#undef PG8_MMA
#undef PG8_WAIT_V
#undef PG8_WAIT_L
#undef PG8_BAR
#undef PG8_SCHED
}
}
#define XB_TMO      128
#define XB_XCNT(j)  (256  + 64 * (j))
#define XB_XSUB(j)  (1280 + 64 * (j))
#define XB_XGEN(j)  (2304 + 64 * (j))
#define XB_TOP      3328
#define XB_TOPGEN   3392
#define XCD_BAR_WORDS 3456
#define XB_SPIN_CAP (1u << 18)

__device__ __forceinline__ unsigned xb_ld(unsigned* p)              { return __hip_atomic_load(p, __ATOMIC_RELAXED, __HIP_MEMORY_SCOPE_AGENT); }
__device__ __forceinline__ unsigned xb_add(unsigned* p, unsigned v) { return __hip_atomic_fetch_add(p, v, __ATOMIC_RELAXED, __HIP_MEMORY_SCOPE_AGENT); }
__device__ __forceinline__ unsigned xb_xcc_id() { return (unsigned)__builtin_amdgcn_s_getreg((3 << 11) | 20) & 0xFu; }
#define XB_SPIN(cond, bar) do { unsigned _sp = 0; while (cond) { __builtin_amdgcn_s_sleep(1); \
    if ((++_sp & 255u) == 0u) { if (xb_ld(&(bar)[XB_TMO])) break; if (_sp > XB_SPIN_CAP) { atomicAdd(&(bar)[XB_TMO], 1u); break; } } } } while (0)

struct XcdBarrier {
    unsigned* bar; unsigned x;
    volatile LAS unsigned* st;
};

__device__ __forceinline__ XcdBarrier xcd_barrier_post(unsigned* bar, volatile LAS unsigned* st) {
    XcdBarrier b; b.bar = bar; b.x = xb_xcc_id(); b.st = st;
    if (threadIdx.x == 0) (void)xb_add(&bar[XB_XCNT(b.x)], 1u);
    return b;
}
__device__ __forceinline__ void xcd_barrier_complete(unsigned* bar, unsigned x, unsigned& nloc, unsigned& nx) {
    const unsigned G = gridDim.x * gridDim.y * gridDim.z;
    unsigned sum, cnt, mine, sp = 0u;
    for (;;) {
        sum = 0u; cnt = 0u; mine = 0u;
#pragma unroll
        for (unsigned j = 0; j < 16; ++j) { const unsigned c = xb_ld(&bar[XB_XCNT(j)]); sum += c; cnt += (c > 0u) ? 1u : 0u; mine = (j == x) ? c : mine; }
        if (sum == G) break;
        __builtin_amdgcn_s_sleep(1);
        if ((++sp & 255u) == 0u) { if (xb_ld(&bar[XB_TMO])) break; if (sp > XB_SPIN_CAP) { atomicAdd(&bar[XB_TMO], 1u); break; } }
    }
    nloc = mine > 0u ? mine : 1u; nx = cnt > 0u ? cnt : 1u;
}

__device__ __forceinline__ void xcd_barrier(const XcdBarrier& b) {
    asm volatile("s_waitcnt vmcnt(0)" ::: "memory");
    __syncthreads();
    if (threadIdx.x == 0) {
        unsigned* bar = b.bar;
        __builtin_amdgcn_s_waitcnt(0);
        unsigned nloc = b.st[0], nx = b.st[1];
        if (nloc == 0u) { xcd_barrier_complete(bar, b.x, nloc, nx); b.st[0] = nloc; b.st[1] = nx; }
        const unsigned old = xb_add(&bar[XB_XSUB(b.x)], 1u);
        const unsigned gen = old / nloc;
        if (old + 1u == (gen + 1u) * nloc) {
            __builtin_amdgcn_fence(__ATOMIC_RELEASE, "agent");
            asm volatile("s_waitcnt vmcnt(0)" ::: "memory");
            const unsigned og = xb_add(&bar[XB_TOP], 1u);
            const unsigned tg = og / nx;
            if (og + 1u == (tg + 1u) * nx) xb_add(&bar[XB_TOPGEN], 1u);
            else XB_SPIN(xb_ld(&bar[XB_TOPGEN]) == tg, bar);
            __builtin_amdgcn_fence(__ATOMIC_ACQUIRE, "agent");
            xb_add(&bar[XB_XGEN(b.x)], 1u);
            asm volatile("s_waitcnt vmcnt(0)" ::: "memory");
        } else {
            XB_SPIN(xb_ld(&bar[XB_XGEN(b.x)]) == gen, bar);
            __builtin_amdgcn_fence(__ATOMIC_ACQUIRE, "agent");
            asm volatile("s_waitcnt vmcnt(0)" ::: "memory");
        }
    }
    __syncthreads();
}
namespace att {
constexpr int DQ = 64, DV = 128, NW = 8, QBLK = 32, KVBLK = 64, LD = 1024;
constexpr float QSCALE = 0.125f * 1.4426950408889634f;
constexpr float THRL = 11.0f;
constexpr int SHM_V = KVBLK * DV * 2, SHM_K = KVBLK * DQ * 2, SHM_ATTN = 2 * SHM_V + 2 * SHM_K + NW * 64 * 4;
#define AT_KSWZ(row, colB) ((row) * 128 + ((colB) ^ ((((row) >> 1) & 7) << 4)))
#define AT_SBAR() __builtin_amdgcn_sched_barrier(0)
#define AT_BAR() do { asm volatile("s_waitcnt lgkmcnt(0)" ::: "memory"); __builtin_amdgcn_s_barrier(); asm volatile("" ::: "memory"); } while (0)
__device__ __forceinline__ int crow(int r, int hi) { return (r & 3) + 8 * (r >> 2) + 4 * hi; }

constexpr int VT_LD = 8192;
struct CvCfg { const float* wg; const float* wu; const float* wd; bf16_t* wgu; bf16_t* wdt; int stride; };
struct CvState { int t, rem, it; const float* src; bf16_t* dst; f32x4 R; };
__device__ __forceinline__ void cv_setup(CvState& c, const CvCfg& g) {
  int it = c.it;
  if (it < 16384) { const int e = (it < 10240) ? (it >> 9) + 12 : (it >> 9) - 20; const int q = it & 511, kb = q >> 5, nb = q & 31;
    c.src = g.wd + (size_t)e * (1024 * 1024) + (size_t)(64 * kb) * 1024 + 32 * nb;
    c.dst = g.wdt + (size_t)e * (1024 * 1024) + (size_t)(32 * nb) * 1024 + 64 * kb; }
  else { it -= 16384; const int up = it >> 14; it &= 16383; const int e = it >> 9, q = it & 511, kb = q >> 5, nb = q & 31, n0 = 32 * nb;
    c.src = (up ? g.wu : g.wg) + (size_t)e * (1024 * 1024) + (size_t)(64 * kb) * 1024 + n0;
    c.dst = g.wgu + ((size_t)e * 2048 + (n0 >> 7) * 256 + up * 128 + (n0 & 127)) * 1024 + 64 * kb; }
}
constexpr int CV_PITCH = 68, CV_SCR_BYTES = 32 * CV_PITCH * 4;
__device__ __forceinline__ void cv_consume(CvState& c, LAS float* scr, int lane, f32x4& T0, f32x4& T1) {
  if (c.rem <= 0) return;
  const int t = c.t, l8 = lane >> 3, l7 = lane & 7;
  if (t >= 1 && t <= 8) { LAS float* w = scr + (4 * l7) * CV_PITCH + l8 + 8 * (t - 1); w[0] = c.R[0]; w[CV_PITCH] = c.R[1]; w[2 * CV_PITCH] = c.R[2]; w[3 * CV_PITCH] = c.R[3]; }
  if (t >= 8) { const LAS float* s = scr + (l8 + 8 * (t - 8)) * CV_PITCH + 8 * l7; T0 = *(const LAS f32x4*)s; T1 = *(const LAS f32x4*)(s + 4); }
}
__device__ __forceinline__ void cv_issue(CvState& c, const CvCfg& g, int lane, const f32x4& T0, const f32x4& T1) {
  if (c.rem <= 0) return;
  const int t = c.t, l8 = lane >> 3, l7 = lane & 7;
  if (t < 8) c.R = __builtin_nontemporal_load((const f32x4*)(c.src + (size_t)(8 * t) * 1024 + (l8 * 1024 + 4 * l7)));
  else { u32x4 o; o.x = cvt_pk_bf16(T0[0], T0[1]); o.y = cvt_pk_bf16(T0[2], T0[3]); o.z = cvt_pk_bf16(T1[0], T1[1]); o.w = cvt_pk_bf16(T1[2], T1[3]);
    __builtin_nontemporal_store(o, (u32x4*)(c.dst + (size_t)(8 * (t - 8)) * 1024 + (l8 * 1024 + 8 * l7))); }
  c.t = t + 1;
  if (c.t == 12) { c.t = 0; --c.rem; c.it += g.stride; if (c.rem > 0) cv_setup(c, g); }
}
template <int HALF_>
__device__ __forceinline__ void attn_half(const bf16_t* __restrict__ Qb, const bf16_t* __restrict__ Kh, const bf16_t* __restrict__ Vt, bf16_t* __restrict__ Ob, int seq, char* lds, CvState& cv, const CvCfg& cg, LAS float* scr, int pm, float lam, const float* __restrict__ dgp) {
  constexpr int KOFF = HALF_ ? 2 : 1;
  const int tid = threadIdx.x, wid = tid >> 6, lane = tid & 63, r32 = lane & 31, hi = lane >> 5;
  char* K_lds = lds; char* V_lds = lds + 2 * SHM_K;
  float* wsf = (float*)(lds + 2 * SHM_V + 2 * SHM_K) + wid * 64;
  float mhat = 0.f, l_reg = 0.f; f32x16 o[4] = {}; bf16x8 qr[4]; f32x16 negm = {};
  { const GAS char* QbU = (const GAS char*)(((unsigned long long)(unsigned)__builtin_amdgcn_readfirstlane((int)((unsigned long long)Qb >> 32)) << 32) | (unsigned long long)(unsigned)__builtin_amdgcn_readfirstlane((int)(unsigned)(unsigned long long)Qb));
    unsigned qoff0 = (unsigned)((wid * QBLK + r32) * LD + hi * 8) * 2u; asm volatile("" : "+v"(qoff0));
#pragma unroll
    for (int d0 = 0; d0 < 4; ++d0) qr[d0] = *(const GAS bf16x8*)(QbU + (qoff0 + (unsigned)(d0 * 32))); }
  const int kr = tid >> 3, kc = (tid & 7) * 8, kst = AT_KSWZ(kr, kc * 2);
  const int kx_ = ((r32 >> 1) & 7) << 4, kbase_ = (int)(uintptr_t)K_lds + r32 * 128;
  const int ka0 = kbase_ + ((hi * 16) ^ kx_), ka1 = kbase_ + ((32 + hi * 16) ^ kx_), ka2 = kbase_ + ((64 + hi * 16) ^ kx_), ka3 = kbase_ + ((96 + hi * 16) ^ kx_);
  const int NT = seq / KVBLK;
  bf16x8 kreg0, kreg1, vreg00, vreg01;
  const GAS char* KhU = (const GAS char*)(((unsigned long long)(unsigned)__builtin_amdgcn_readfirstlane((int)((unsigned long long)Kh >> 32)) << 32) | (unsigned long long)(unsigned)__builtin_amdgcn_readfirstlane((int)(unsigned)(unsigned long long)Kh));
  const GAS char* VtU = (const GAS char*)(((unsigned long long)(unsigned)__builtin_amdgcn_readfirstlane((int)((unsigned long long)Vt >> 32)) << 32) | (unsigned long long)(unsigned)__builtin_amdgcn_readfirstlane((int)(unsigned)(unsigned long long)Vt));
  unsigned koff0 = (unsigned)(kr * LD + kc) * 2u, voff0 = (unsigned)(kr * VT_LD + kc) * 2u;
  asm volatile("" : "+v"(koff0), "+v"(voff0));
#define AT_KLOAD(j) (*(const GAS bf16x8*)(KhU + (koff0 + (unsigned)(j) * (unsigned)(KVBLK * LD * 2))))
#define AT_VLOAD0(j) (*(const GAS bf16x8*)(VtU + (voff0 + (unsigned)(j) * (unsigned)(KVBLK * 2))))
#define AT_VLOAD1(j) (*(const GAS bf16x8*)(VtU + (voff0 + (unsigned)(j) * (unsigned)(KVBLK * 2) + (unsigned)(64 * VT_LD * 2))))
  kreg0 = AT_KLOAD(0); kreg1 = AT_KLOAD(1); vreg00 = AT_VLOAD0(0); vreg01 = AT_VLOAD1(0);
  *(bf16x8*)(K_lds + kst) = kreg0; *(bf16x8*)(K_lds + SHM_K + kst) = kreg1;
  *(bf16x8*)(V_lds + kst) = vreg00; *(bf16x8*)(V_lds + 8192 + kst) = vreg01;
  kreg0 = AT_KLOAD(2); vreg00 = AT_VLOAD0(1); vreg01 = AT_VLOAD1(1);
  f32x16 p0, p1; bf16x8 pa0, pa1, pa2, pa3;
  bf16x8 f0, f1, f2, f3, f4, f5, f6, f7;
  AT_BAR();
#define AT_RD(dst, i, PAR) do { if ((i) < 8) asm volatile("ds_read_b128 %0, %1 offset:%2" : "=&v"(dst) : "v"(AT_KA((i) >> 1)), "i"((PAR) * SHM_K + ((i) & 1) * 4096) : "memory"); \
    else asm volatile("ds_read_b128 %0, %1 offset:%2" : "=&v"(dst) : "v"(AT_KA(((i) - 8) >> 2)), "i"(2 * SHM_K + (1 - (PAR)) * SHM_V + (((i) - 8) & 3) * 4096) : "memory"); } while (0)
#define AT_KA(c) ((c) == 0 ? ka0 : (c) == 1 ? ka1 : (c) == 2 ? ka2 : ka3)
#define AT_PA(c) ((c) == 0 ? pa0 : (c) == 1 ? pa1 : (c) == 2 ? pa2 : pa3)
#define AT_MM(src, i) do { if ((i) < 2) { if ((i) == 0) p0 = __builtin_amdgcn_mfma_f32_32x32x16_bf16(src, qr[0], negm, 0, 0, 0); else p1 = __builtin_amdgcn_mfma_f32_32x32x16_bf16(src, qr[0], negm, 0, 0, 0); } \
    else if ((i) < 8) { if (((i) & 1) == 0) p0 = __builtin_amdgcn_mfma_f32_32x32x16_bf16(src, qr[((i) >> 1) & 3], p0, 0, 0, 0); else p1 = __builtin_amdgcn_mfma_f32_32x32x16_bf16(src, qr[((i) >> 1) & 3], p1, 0, 0, 0); } \
    else o[((i) - 8) & 3] = __builtin_amdgcn_mfma_f32_32x32x16_bf16(AT_PA(((i) - 8) >> 2), src, o[((i) - 8) & 3], 0, 0, 0); } while (0)
#define AT_WLX(n) do { asm volatile("s_waitcnt lgkmcnt(%0)" :: "n"(n) : "memory"); AT_SBAR(); } while (0)
#define AT_WL(n) do { if ((n) >= 5) asm volatile("s_waitcnt lgkmcnt(5)" ::: "memory"); else if ((n) == 4) asm volatile("s_waitcnt lgkmcnt(4)" ::: "memory"); else if ((n) == 3) asm volatile("s_waitcnt lgkmcnt(3)" ::: "memory"); \
    else if ((n) == 2) asm volatile("s_waitcnt lgkmcnt(2)" ::: "memory"); else if ((n) == 1) asm volatile("s_waitcnt lgkmcnt(1)" ::: "memory"); else asm volatile("s_waitcnt lgkmcnt(0)" ::: "memory"); AT_SBAR(); } while (0)
#define AT_STEP(i, N, PAR) do { AT_WL((N) - 1 - (i)); AT_MM(AT_F(i), i); AT_SBAR(); if ((i) + 6 < (N)) AT_RD(AT_F((i) + 6), (i) + 6, PAR); } while (0)
#define AT_F(i) f##i
#define AT_XPRE(PAR) do { AT_RD(f0, 0, PAR); AT_RD(f1, 1, PAR); AT_RD(f2, 2, PAR); AT_RD(f3, 3, PAR); AT_RD(f4, 4, PAR); AT_RD(f5, 5, PAR); AT_RD(f6, 6, PAR); AT_RD(f7, 7, PAR); } while (0)
#define AT_X(s, PAR) do { AT_SBAR(); AT_PRIO(1);  AT_PK4(p0, 0, pa0); AT_PK4(p0, 8, pa1); asm volatile("" : "+v"(pa0), "+v"(pa1)); AT_SBAR();  AT_MM(f0, 0); AT_SBAR(); AT_PK4(p1, 0, pa2); AT_PK4(p1, 8, pa3); asm volatile("" : "+v"(pa2), "+v"(pa3)); AT_SBAR();  AT_MM(f1, 1); AT_SBAR(); AT_MM(f2, 2); AT_SBAR(); AT_RD(f0, 8, PAR); AT_MM(f3, 3); AT_SBAR(); AT_RD(f1, 9, PAR); AT_MM(f4, 4); AT_SBAR(); AT_RD(f2, 10, PAR); AT_MM(f5, 5); AT_SBAR(); AT_RD(f3, 11, PAR); AT_MM(f6, 6); AT_SBAR(); AT_RD(f4, 12, PAR); AT_MM(f7, 7); AT_SBAR(); AT_RD(f5, 13, PAR); AT_WLX(5); AT_MM(f0, 8); AT_SBAR(); AT_RD(f6, 14, PAR); AT_WLX(5); AT_MM(f1, 9); AT_SBAR(); AT_RD(f7, 15, PAR); AT_WLX(5); AT_MM(f2, 10); AT_SBAR(); AT_RD(f0, 16, PAR); AT_WLX(5); AT_MM(f3, 11); AT_SBAR(); AT_RD(f1, 17, PAR); AT_WLX(5); AT_MM(f4, 12); AT_SBAR(); AT_RD(f2, 18, PAR); AT_WLX(5); AT_MM(f5, 13); AT_SBAR(); AT_RD(f3, 19, PAR); AT_WLX(5); AT_MM(f6, 14); AT_SBAR(); AT_RD(f4, 20, PAR); AT_WLX(5); AT_MM(f7, 15); AT_SBAR(); AT_RD(f5, 21, PAR); AT_WLX(5); AT_MM(f0, 16); AT_SBAR(); AT_RD(pa0, 22, PAR); AT_RD(f6, 6, 1 - (PAR)); AT_WLX(6); AT_MM(f1, 17); AT_SBAR(); AT_RD(pa1, 23, PAR); AT_RD(f7, 7, 1 - (PAR)); AT_WLX(7); AT_MM(f2, 18); AT_SBAR(); AT_RD(f0, 0, 1 - (PAR)); AT_WLX(7); AT_MM(f3, 19); AT_SBAR(); AT_RD(f1, 1, 1 - (PAR)); AT_WLX(7); AT_MM(f4, 20); AT_SBAR(); AT_RD(f2, 2, 1 - (PAR)); AT_WLX(7); AT_MM(f5, 21); AT_SBAR(); AT_RD(f3, 3, 1 - (PAR)); AT_WLX(7); AT_MM(pa0, 22); AT_SBAR(); AT_RD(f4, 4, 1 - (PAR)); AT_RD(f5, 5, 1 - (PAR)); AT_WLX(7); AT_MM(pa1, 23); AT_SBAR();  AT_PRIO(0); } while (0)
#define AT_XL(PAR) do { AT_SBAR(); AT_PRIO(1); AT_PK4(p0, 0, pa0); AT_PK4(p0, 8, pa1); asm volatile("" : "+v"(pa0), "+v"(pa1)); AT_SBAR(); AT_MM(f0, 0); AT_SBAR(); AT_PK4(p1, 0, pa2); AT_PK4(p1, 8, pa3); asm volatile("" : "+v"(pa2), "+v"(pa3)); AT_SBAR(); AT_MM(f1, 1); AT_SBAR(); AT_MM(f2, 2); AT_SBAR(); AT_RD(f0, 8, PAR); AT_MM(f3, 3); AT_SBAR(); AT_RD(f1, 9, PAR); AT_MM(f4, 4); AT_SBAR(); AT_RD(f2, 10, PAR); AT_MM(f5, 5); AT_SBAR(); AT_RD(f3, 11, PAR); AT_MM(f6, 6); AT_SBAR(); AT_RD(f4, 12, PAR); AT_MM(f7, 7); AT_SBAR(); AT_RD(f5, 13, PAR); AT_WL(15); AT_MM(f0, 8); AT_SBAR(); AT_RD(f6, 14, PAR); AT_WL(14); AT_MM(f1, 9); AT_SBAR(); AT_RD(f7, 15, PAR); AT_WL(13); AT_MM(f2, 10); AT_SBAR(); AT_RD(f0, 16, PAR); AT_WL(12); AT_MM(f3, 11); AT_SBAR(); AT_RD(f1, 17, PAR); AT_WL(11); AT_MM(f4, 12); AT_SBAR(); AT_RD(f2, 18, PAR); AT_WL(10); AT_MM(f5, 13); AT_SBAR(); AT_RD(f3, 19, PAR); AT_WL(9); AT_MM(f6, 14); AT_SBAR(); AT_RD(f4, 20, PAR); AT_WL(8); AT_MM(f7, 15); AT_SBAR(); AT_RD(f5, 21, PAR); AT_WL(7); AT_MM(f0, 16); AT_SBAR(); AT_RD(f6, 22, PAR); AT_WL(6); AT_MM(f1, 17); AT_SBAR(); AT_RD(f7, 23, PAR); AT_WL(5); AT_MM(f2, 18); AT_SBAR(); AT_WL(4); AT_MM(f3, 19); AT_SBAR(); AT_WL(3); AT_MM(f4, 20); AT_SBAR(); AT_WL(2); AT_MM(f5, 21); AT_SBAR(); AT_WL(1); AT_MM(f6, 22); AT_SBAR(); AT_WL(0); AT_MM(f7, 23); AT_SBAR(); AT_PRIO(0); } while (0)
#define AT_X0() do { AT_SBAR(); AT_PRIO(1); AT_MM(f0, 0); AT_SBAR(); AT_MM(f1, 1); AT_SBAR(); AT_MM(f2, 2); AT_SBAR(); AT_MM(f3, 3); AT_SBAR(); AT_MM(f4, 4); AT_SBAR(); AT_MM(f5, 5); AT_SBAR(); AT_MM(f6, 6); AT_SBAR(); AT_MM(f7, 7); AT_SBAR(); AT_XPRE(1); AT_PRIO(0); } while (0)
#define AT_S(i, r, N, PAR) do { AT_WL((N) - 1 - (i)); AT_MM(f##r, i); AT_SBAR(); } while (0)
#define AT_PRIO(n) do { if (n) __builtin_amdgcn_s_setprio(HALF_ ? 3 : 2); else __builtin_amdgcn_s_setprio(HALF_ ? 1 : 0); } while (0)
#define AT_PK4(P, BASE, OUT) do { u32x4 w = {cvt_pk_bf16(P[BASE + 0], P[BASE + 1]), cvt_pk_bf16(P[BASE + 2], P[BASE + 3]), cvt_pk_bf16(P[BASE + 4], P[BASE + 5]), cvt_pk_bf16(P[BASE + 6], P[BASE + 7])}; \
    OUT = *reinterpret_cast<bf16x8*>(&w); } while (0)
#define AT_Y(s, KPAR, FIRST) do { \
    { const int jk = (s) + KOFF + 1, jv = (s) + KOFF - 1; const bool ks = jk >= 3 && jk < NT, vs = jv >= 1 && jv < NT;        \
      f32x4 cvT0, cvT1; cv_consume(cv, scr, lane, cvT0, cvT1); \
      if (ks) { if (!(KPAR)) *(bf16x8*)(K_lds + SHM_K + kst) = kreg0; else *(bf16x8*)(K_lds + kst) = kreg0; } \
      if (vs) { if (KPAR) { *(bf16x8*)(V_lds + kst) = vreg00; *(bf16x8*)(V_lds + 8192 + kst) = vreg01; } else { *(bf16x8*)(V_lds + SHM_V + kst) = vreg00; *(bf16x8*)(V_lds + SHM_V + 8192 + kst) = vreg01; } } \
      asm volatile("" ::: "memory"); AT_SBAR(); \
      cv_issue(cv, cg, lane, cvT0, cvT1); \
      if (ks && jk + 1 < NT) kreg0 = AT_KLOAD(jk + 1);        \
      if (vs && jv + 1 < NT) { vreg00 = AT_VLOAD0(jv + 1); vreg01 = AT_VLOAD1(jv + 1); } } \
    { float pmax = fmaxf(p0[0], p1[0]); \
      _Pragma("unroll") for (int r = 1; r < 16; ++r) pmax = fmaxf(fmaxf(pmax, p0[r]), p1[r]); \
      { auto rr = __builtin_amdgcn_permlane32_swap(__float_as_uint(pmax), __float_as_uint(pmax), false, false); pmax = fmaxf(__uint_as_float(rr[0]), __uint_as_float(rr[1])); } \
      const bool first = (FIRST); \
      if (first || __any(pmax > THRL)) { \
        const float dl = first ? pmax : fmaxf(pmax, 0.f); mhat += dl; \
        _Pragma("unroll") for (int r = 0; r < 16; ++r) { p0[r] -= dl; p1[r] -= dl; } \
        if (!first) { const float f = __builtin_amdgcn_exp2f(-dl); l_reg *= f; if (hi == 0) wsf[r32] = f; asm volatile("s_waitcnt lgkmcnt(0)" ::: "memory"); \
          _Pragma("unroll") for (int d = 0; d < 4; ++d) _Pragma("unroll") for (int r = 0; r < 16; ++r) o[d][r] *= wsf[crow(r, hi)]; } } \
      { float nm = -mhat; asm volatile("" : "+v"(nm)); _Pragma("unroll") for (int r = 0; r < 16; ++r) negm[r] = nm; } \
      _Pragma("unroll") for (int r = 0; r < 16; ++r) { p0[r] = __builtin_amdgcn_exp2f(p0[r]); p1[r] = __builtin_amdgcn_exp2f(p1[r]); } \
      f32x2 ps2a = {p0[0], p0[1]}, ps2b = {p1[0], p1[1]}; \
      _Pragma("unroll") for (int r = 2; r < 16; r += 2) { ps2a += (f32x2){p0[r], p0[r + 1]}; ps2b += (f32x2){p1[r], p1[r + 1]}; }        \
      ps2a += ps2b; float ps = ps2a[0] + ps2a[1]; \
      { auto rr = __builtin_amdgcn_permlane32_swap(__float_as_uint(ps), __float_as_uint(ps), false, false); ps = __uint_as_float(rr[0]) + __uint_as_float(rr[1]); } \
      l_reg += ps; \
      } \
  } while (0)
  AT_XPRE(0);
  AT_BAR();
  *(bf16x8*)(K_lds + kst) = kreg0; kreg0 = AT_KLOAD(3);
  if (HALF_ == 1) AT_BAR();
  if (HALF_ == 1) __builtin_amdgcn_s_setprio(1);
  AT_X0(); AT_BAR();
  AT_Y(0, (KOFF & 1), true); AT_BAR();
  for (int s = 1; s + 1 < NT; s += 2) {
    AT_X(s, 1); AT_BAR();
    AT_Y(s, ((KOFF + 1) & 1), false); AT_BAR();
    AT_X(s + 1, 0); AT_BAR();
    AT_Y(s + 1, (KOFF & 1), false); AT_BAR();
  }
  AT_XL(1); AT_BAR();
  AT_Y(NT - 1, ((KOFF + 1) & 1), false); AT_BAR();
  { AT_SBAR();
    AT_PK4(p0, 0, pa0); AT_PK4(p0, 8, pa1); AT_PK4(p1, 0, pa2); AT_PK4(p1, 8, pa3);
    AT_RD(f0, 8, 0); AT_RD(f1, 9, 0); AT_RD(f2, 10, 0); AT_RD(f3, 11, 0); AT_RD(f4, 12, 0); AT_RD(f5, 13, 0);
    AT_S(8, 0, 24, 0);  AT_RD(f6, 14, 0);  AT_S(9, 1, 24, 0);  AT_RD(f7, 15, 0);  AT_S(10, 2, 24, 0); AT_RD(f0, 16, 0);  AT_S(11, 3, 24, 0); AT_RD(f1, 17, 0);
    AT_S(12, 4, 24, 0); AT_RD(f2, 18, 0);  AT_S(13, 5, 24, 0); AT_RD(f3, 19, 0);  AT_S(14, 6, 24, 0); AT_RD(f4, 20, 0);  AT_S(15, 7, 24, 0); AT_RD(f5, 21, 0);
    AT_S(16, 0, 24, 0); AT_RD(f6, 22, 0);  AT_S(17, 1, 24, 0); AT_RD(f7, 23, 0);  AT_S(18, 2, 24, 0); AT_S(19, 3, 24, 0); AT_S(20, 4, 24, 0); AT_S(21, 5, 24, 0); AT_S(22, 6, 24, 0); AT_S(23, 7, 24, 0); }
  if (HALF_ == 1) __builtin_amdgcn_s_setprio(0);
  if (HALF_ == 0) AT_BAR();
  if (hi == 0) wsf[32 + r32] = l_reg; asm volatile("s_waitcnt lgkmcnt(0)" ::: "memory");
  float rli[16];
#pragma unroll
  for (int r = 0; r < 16; ++r) rli[r] = __builtin_amdgcn_rcpf(wsf[32 + crow(r, hi)]);
  GAS char* ObU = (GAS char*)(((unsigned long long)(unsigned)__builtin_amdgcn_readfirstlane((int)((unsigned long long)Ob >> 32)) << 32) | (unsigned long long)(unsigned)__builtin_amdgcn_readfirstlane((int)(unsigned)(unsigned long long)Ob));
  unsigned ooff0 = (unsigned)((wid * QBLK + 4 * hi) * LD + r32) * 2u; asm volatile("" : "+v"(ooff0));
#define AT_OOFF(r, d0) (ooff0 + (unsigned)((((r & 3) + 8 * (r >> 2)) * LD + d0 * 32) * 2))
  if (pm == 0) {
#pragma unroll
    for (int r = 0; r < 16; ++r) {
#pragma unroll
      for (int d0 = 0; d0 < 4; ++d0) *(GAS bf16_t*)(ObU + AT_OOFF(r, d0)) = (bf16_t)(cvt_pk_bf16(o[d0][r] * rli[r], 0.f) & 0xffffu); }
  } else {
    unsigned short o1r[4][16];
#pragma unroll
    for (int r = 0; r < 16; ++r) {
#pragma unroll
      for (int d0 = 0; d0 < 4; ++d0) o1r[d0][r] = *(const GAS unsigned short*)(ObU + AT_OOFF(r, d0)); }
    float dgv[4];
#pragma unroll
    for (int d0 = 0; d0 < 4; ++d0) dgv[d0] = dgp[32 * d0 + r32] * (1.f - LAM_INIT);
#pragma unroll
    for (int r = 0; r < 16; ++r) {
      float ss = 0.f;
#pragma unroll
      for (int d0 = 0; d0 < 4; ++d0) { const float df = __uint_as_float((unsigned)o1r[d0][r] << 16) - lam * (o[d0][r] * rli[r]); o[d0][r] = df; ss += df * df; }
#pragma unroll
      for (int sft = 1; sft < 32; sft <<= 1) ss += __shfl_xor(ss, sft);
      const float rs = __builtin_amdgcn_rsqf(ss * (1.f / 128.f) + LN_EPS);
#pragma unroll
      for (int d0 = 0; d0 < 4; ++d0) *(GAS bf16_t*)(ObU + AT_OOFF(r, d0)) = (bf16_t)(cvt_pk_bf16(o[d0][r] * rs * dgv[d0], 0.f) & 0xffffu);
    }
  }
#undef AT_OOFF
#undef AT_KLOAD
#undef AT_XPRE
#undef AT_XL
#undef AT_VLOAD0
#undef AT_VLOAD1
#undef AT_RD
#undef AT_KA
#undef AT_PA
#undef AT_MM
#undef AT_WL
#undef AT_STEP
#undef AT_F
#undef AT_X
#undef AT_X0
#undef AT_S
#undef AT_XSTEPS
#undef AT_XSTEPS8
#undef AT_PRIO
#undef AT_PK4
#undef AT_Y
}
__device__ __forceinline__ void attn_dense_body(const bf16_t* __restrict__ Qb, const bf16_t* __restrict__ Kh, const bf16_t* __restrict__ Vh, bf16_t* __restrict__ Ob, int seq, char* lds, int half, CvState& cv, const CvCfg& cg, LAS float* scr, int pm, float lam, const float* __restrict__ dgp) {
  if (half == 0) attn_half<0>(Qb, Kh, Vh, Ob, seq, lds, cv, cg, scr, pm, lam, dgp); else attn_half<1>(Qb, Kh, Vh, Ob, seq, lds, cv, cg, scr, pm, lam, dgp);
  AT_BAR();
}
#undef AT_SBAR
#undef AT_BAR
}

namespace gla {
__device__ __forceinline__ int crow(int r, int hi) { return (r & 3) + 8 * (r >> 2) + 4 * hi; }
constexpr int P128 = 272, P64 = 144;
constexpr int L_QI = 0, L_KI = L_QI + 64 * P128, L_KST = L_KI + 64 * P128, L_VT = L_KST + 128 * P64, L_ST = L_VT + 128 * P64, L_ATT = L_ST + 128 * P128, L_DEC = L_ATT + 64 * P64, L_END = L_DEC + 512;
static_assert(L_END <= 131072, "GLA LDS map");
constexpr int NSEG = 8, CPS = 16;

__device__ __forceinline__ bf16x8 frag(const LAS unsigned char* p) { return *(const LAS bf16x8*)p; }
#define SWZ64(R, G) ((R) * P64 + 16 * ((G) ^ (((R) >> 4) & 7)))
#define GLA_MFMA(a, b, c) __builtin_amdgcn_mfma_f32_32x32x16_bf16((a), (b), (c), 0, 0, 0)
#define GLA_BAR() do { asm volatile("s_waitcnt lgkmcnt(0)" ::: "memory"); __builtin_amdgcn_s_barrier(); asm volatile("" ::: "memory"); } while (0)

__device__ __forceinline__ void g0_chunk(LAS unsigned char* lds, int ch, const bf16_t* h0, const bf16_t* wlr  , const float* wf_f, const float* bf_f, const float* wf_b, const float* bf_b, float* BF, float* BB) {
    const int tid = threadIdx.x, w = __builtin_amdgcn_readfirstlane(tid >> 6), lane = tid & 63, r = lane & 31, hh = lane >> 5;
    const int row0 = ch * 64, rh = w & 1, kq = w >> 1;
    LAS float* P = (LAS float*)lds;
    float wv[2][2][8], bsv[2][2];
#pragma unroll
    for (int dir = 0; dir < 2; ++dir)
#pragma unroll
        for (int cbi = 0; cbi < 2; ++cbi) { const float* W = dir ? wf_b : wf_f; const int col = 64 * w + 32 * cbi + r;
#pragma unroll
            for (int j = 0; j < 8; ++j) wv[dir][cbi][j] = W[(8 * hh + j) * 512 + col];
            bsv[dir][cbi] = (dir ? bf_b : bf_f)[col]; }
    LAS float* LR = (LAS float*)(lds + 32768);
    {
        f32x16 acc = {};
        const bf16_t* ap = h0 + (size_t)(row0 + 32 * rh + r) * D + kq * 256 + 8 * hh;
        const bf16_t* bp = wlr + (size_t)r * D + kq * 256 + 8 * hh;
#pragma unroll 8
        for (int s = 0; s < 16; ++s) { const bf16x8 a = *(const bf16x8*)(ap + 16 * s), b = *(const bf16x8*)(bp + 16 * s); acc = GLA_MFMA(a, b, acc); }
#pragma unroll
        for (int q = 0; q < 16; ++q) P[(kq * 64 + 32 * rh + crow(q, hh)) * 32 + r] = acc[q];
    }
    GLA_BAR();
#pragma unroll
    for (int q = 0; q < 4; ++q) { const int idx = tid + 512 * q; LR[idx] = (P[idx] + P[2048 + idx]) + (P[4096 + idx] + P[6144 + idx]); }
    GLA_BAR();
#pragma unroll
    for (int dir = 0; dir < 2; ++dir) {
        float* OUT = dir ? BB : BF;
        bf16x8 ah[2], al[2];
#pragma unroll
        for (int rb = 0; rb < 2; ++rb) { const f32x4 a0 = *(const LAS f32x4*)(LR + (32 * rb + r) * 32 + 16 * dir + 8 * hh), a1 = *(const LAS f32x4*)(LR + (32 * rb + r) * 32 + 16 * dir + 8 * hh + 4);
            u32x4 h4, l4;
            h4[0] = cvt_pk_bf16(a0[0], a0[1]); h4[1] = cvt_pk_bf16(a0[2], a0[3]); h4[2] = cvt_pk_bf16(a1[0], a1[1]); h4[3] = cvt_pk_bf16(a1[2], a1[3]);
            l4[0] = cvt_pk_bf16(a0[0] - bflo(h4[0]), a0[1] - bfhi(h4[0])); l4[1] = cvt_pk_bf16(a0[2] - bflo(h4[1]), a0[3] - bfhi(h4[1]));
            l4[2] = cvt_pk_bf16(a1[0] - bflo(h4[2]), a1[1] - bfhi(h4[2])); l4[3] = cvt_pk_bf16(a1[2] - bflo(h4[3]), a1[3] - bfhi(h4[3]));
            ah[rb] = __builtin_bit_cast(bf16x8, h4); al[rb] = __builtin_bit_cast(bf16x8, l4); }
#pragma unroll
        for (int cbi = 0; cbi < 2; ++cbi) {
            const int col = 64 * w + 32 * cbi + r;
            const float bs = bsv[dir][cbi];
            u32x4 h4, l4;
#pragma unroll
            for (int j = 0; j < 4; ++j) { h4[j] = cvt_pk_bf16(wv[dir][cbi][2 * j], wv[dir][cbi][2 * j + 1]); l4[j] = cvt_pk_bf16(wv[dir][cbi][2 * j] - bflo(h4[j]), wv[dir][cbi][2 * j + 1] - bfhi(h4[j])); }
            const bf16x8 bh = __builtin_bit_cast(bf16x8, h4), bl = __builtin_bit_cast(bf16x8, l4);
            f32x16 x[2];
#pragma unroll
            for (int rb = 0; rb < 2; ++rb) { f32x16 z = {}; z = GLA_MFMA(ah[rb], bh, z); z = GLA_MFMA(ah[rb], bl, z); z = GLA_MFMA(al[rb], bh, z); x[rb] = z; }
            float s[2][4], pp[2][4];
#pragma unroll
            for (int rb = 0; rb < 2; ++rb)
#pragma unroll
                for (int q = 0; q < 16; ++q) { const float x2 = (x[rb][q] + bs) * 1.4426950408889634f; x[rb][q] = (fminf(x2, 0.f) - __builtin_amdgcn_logf(1.0f + __builtin_amdgcn_exp2f(-fabsf(x2)))) * 0.0625f; }
#pragma unroll
            for (int rb = 0; rb < 2; ++rb)
#pragma unroll
                for (int gq = 0; gq < 4; ++gq) { s[rb][gq] = (x[rb][4 * gq] + x[rb][4 * gq + 1]) + (x[rb][4 * gq + 2] + x[rb][4 * gq + 3]); pp[rb][gq] = __shfl_xor(s[rb][gq], 32); }
            float run = 0.f;
            if (dir == 0) {
#pragma unroll
                for (int rb = 0; rb < 2; ++rb)
#pragma unroll
                    for (int gq = 0; gq < 4; ++gq) { float t = run + (hh ? pp[rb][gq] : 0.f);
#pragma unroll
                        for (int i = 0; i < 4; ++i) { t += x[rb][4 * gq + i]; x[rb][4 * gq + i] = t; }
                        run += s[rb][gq] + pp[rb][gq]; }
            } else {
#pragma unroll
                for (int rb = 1; rb >= 0; --rb)
#pragma unroll
                    for (int gq = 3; gq >= 0; --gq) { float t = run + (hh ? 0.f : pp[rb][gq]);
#pragma unroll
                        for (int i = 3; i >= 0; --i) { t += x[rb][4 * gq + i]; x[rb][4 * gq + i] = t; }
                        run += s[rb][gq] + pp[rb][gq]; }
            }
#pragma unroll
            for (int rb = 0; rb < 2; ++rb)
#pragma unroll
                for (int q = 0; q < 16; ++q) OUT[(size_t)(row0 + 32 * rb + crow(q, hh)) * 512 + col] = x[rb][q];
        }
    }
    GLA_BAR();
}

struct Args { const bf16_t* qkg; const bf16_t* vg; const float* bf; const float* bb; float* seg; float* segd; bf16_t* of; bf16_t* ob; };

template <bool PASS2>
__device__ __forceinline__ void gla_unit(LAS unsigned char* lds, const Args& a, int unit) {
    const int tid = threadIdx.x, w = __builtin_amdgcn_readfirstlane(tid >> 6), lane = tid & 63, r = lane & 31, hh = lane >> 5;
    const int seg = unit & 7, es = (unit >> 3) & 1, dir = (unit >> 4) & 1, h = (unit >> 5) & 3, b = unit >> 7;
    if (!PASS2 && seg == NSEG - 1) return;
    const int db = w & 3, ebp = w >> 2;
    const int c = tid >> 3, g = tid & 7;
    const int clast = dir ? 0 : 63;
    const float* Bd = dir ? a.bb : a.bf;
    bf16_t* Od = dir ? a.ob : a.of;
    f32x16 S[2]; S[0] = f32x16{}; S[1] = f32x16{};
    float sumb0 = 0.f, sumb1 = 0.f;
    u32x4 q0 = {}, q1 = {}, k0, k1, v0, v1; f32x4 bv[4]; f32x2 ml = {0.f, 0.f};
#define GLA_LOADS(i_) do { const int n_ = seg * CPS + (i_), cn_ = dir ? (127 - n_) : n_; const size_t r0_ = (size_t)b * SEQ + (size_t)cn_ * 64; \
        const bf16_t* qp = a.qkg + (r0_ + c) * D + h * 128 + 16 * g; const bf16_t* kp = qp + 512; \
        const float* bp = Bd + (r0_ + c) * 512 + h * 128 + 16 * g; const float* blp = Bd + (r0_ + clast) * 512 + h * 128 + 16 * g; \
        const bf16_t* vp = a.vg + (r0_ + c) * D + h * 256 + es * 128 + 16 * g; \
        if (PASS2) { q0 = *(const u32x4*)qp; q1 = *(const u32x4*)(qp + 8); } \
        k0 = *(const u32x4*)kp; k1 = *(const u32x4*)(kp + 8); v0 = *(const u32x4*)vp; v1 = *(const u32x4*)(vp + 8); \
        ml = *(const f32x2*)(blp + 2 * (c & 7)); \
        _Pragma("unroll") for (int j = 0; j < 4; ++j) { bv[j] = *(const f32x4*)(bp + 4 * j); } } while (0)
    GLA_LOADS(0);
    if (PASS2) {
#pragma unroll
        for (int i0 = 0; i0 < 9; i0 += 3) {
            float spv[3][32], dpv[3][16];
#pragma unroll
            for (int k = 0; k < 3; ++k) if (i0 + k < seg) {
                const int up = unit - seg + i0 + k;
                const float* sp = a.seg + ((size_t)up * 8 + w) * 2048 + lane; const float* dp = a.segd + (size_t)up * 128 + 32 * db;
#pragma unroll
                for (int q = 0; q < 32; ++q) spv[k][q] = sp[q * 64];
#pragma unroll
                for (int q = 0; q < 16; ++q) dpv[k][q] = dp[crow(q, hh)];
            }
#pragma unroll
            for (int k = 0; k < 3; ++k) if (i0 + k < seg) {
#pragma unroll
                for (int t = 0; t < 2; ++t)
#pragma unroll
                    for (int q = 0; q < 16; ++q) S[t][q] = S[t][q] * dpv[k][q] + spv[k][t * 16 + q];
            }
        }
#pragma unroll
        for (int t = 0; t < 2; ++t)
#pragma unroll
            for (int g4 = 0; g4 < 4; ++g4) { u32x2 pk; pk.x = cvt_pk_bf16(S[t][4 * g4], S[t][4 * g4 + 1]); pk.y = cvt_pk_bf16(S[t][4 * g4 + 2], S[t][4 * g4 + 3]);
                *(LAS u32x2*)(lds + L_ST + (32 * (2 * ebp + t) + r) * P128 + (32 * db + 8 * g4 + 4 * hh) * 2) = pk; }
    }
    for (int i = 0; i < CPS; ++i) {
        const int n = seg * CPS + i, cn = dir ? (127 - n) : n; const size_t row0 = (size_t)b * SEQ + (size_t)cn * 64;
        {
            unsigned qw[8], kw[8], vw[8];
            qw[0] = q0.x; qw[1] = q0.y; qw[2] = q0.z; qw[3] = q0.w; qw[4] = q1.x; qw[5] = q1.y; qw[6] = q1.z; qw[7] = q1.w;
            kw[0] = k0.x; kw[1] = k0.y; kw[2] = k0.z; kw[3] = k0.w; kw[4] = k1.x; kw[5] = k1.y; kw[6] = k1.z; kw[7] = k1.w;
            vw[0] = v0.x; vw[1] = v0.y; vw[2] = v0.z; vw[3] = v0.w; vw[4] = v1.x; vw[5] = v1.y; vw[6] = v1.z; vw[7] = v1.w;
            unsigned qiw[8], kiw[8];
#pragma unroll
            for (int j2 = 0; j2 < 8; ++j2) {
                const float bA = bv[j2 >> 1][(2 * j2) & 3], bB = bv[j2 >> 1][(2 * j2 + 1) & 3];
                const float kA = bflo(kw[j2]), kB = bfhi(kw[j2]);
                const unsigned ks = cvt_pk_bf16(kA * __builtin_amdgcn_exp2f(-bA), kB * __builtin_amdgcn_exp2f(-bB));
                *(LAS unsigned short*)(lds + L_KST + (16 * g + 2 * j2) * P64 + 2 * (c ^ (g << 3))) = (unsigned short)(ks & 0xffffu);
                *(LAS unsigned short*)(lds + L_KST + (16 * g + 2 * j2 + 1) * P64 + 2 * (c ^ (g << 3))) = (unsigned short)(ks >> 16);
                *(LAS unsigned short*)(lds + L_VT + (16 * g + 2 * j2) * P64 + 2 * (c ^ (g << 3))) = (unsigned short)(vw[j2] & 0xffffu);
                *(LAS unsigned short*)(lds + L_VT + (16 * g + 2 * j2 + 1) * P64 + 2 * (c ^ (g << 3))) = (unsigned short)(vw[j2] >> 16);
                if (PASS2) {
                    qiw[j2] = cvt_pk_bf16(bflo(qw[j2]) * __builtin_amdgcn_exp2f(bA), bfhi(qw[j2]) * __builtin_amdgcn_exp2f(bB));
                    kiw[j2] = ks;
                }
            }
            if (c < 8) { *(LAS f32x2*)(lds + L_DEC + (16 * g + 2 * c) * 4) = (f32x2){__builtin_amdgcn_exp2f(ml.x), __builtin_amdgcn_exp2f(ml.y)}; sumb0 += ml.x; sumb1 += ml.y; }
            if (PASS2) {
                *(LAS u32x4*)(lds + L_QI + c * P128 + 32 * g) = (u32x4){qiw[0], qiw[1], qiw[2], qiw[3]}; *(LAS u32x4*)(lds + L_QI + c * P128 + 32 * g + 16) = (u32x4){qiw[4], qiw[5], qiw[6], qiw[7]};
                *(LAS u32x4*)(lds + L_KI + c * P128 + 32 * g) = (u32x4){kiw[0], kiw[1], kiw[2], kiw[3]}; *(LAS u32x4*)(lds + L_KI + c * P128 + 32 * g + 16) = (u32x4){kiw[4], kiw[5], kiw[6], kiw[7]};
            }
        }
        if (i + 1 < CPS) GLA_LOADS(i + 1);
        GLA_BAR();
        if (PASS2) {
            if (w < 4) {
                const int cb = w & 1, mb = w >> 1; f32x16 acc = {};
#pragma unroll
                for (int s = 0; s < 8; ++s) acc = GLA_MFMA(frag(lds + L_QI + (32 * cb + r) * P128 + (16 * s + 8 * hh) * 2), frag(lds + L_KI + (32 * mb + r) * P128 + (16 * s + 8 * hh) * 2), acc);
                const int mm = 32 * mb + r;
#pragma unroll
                for (int q = 0; q < 16; ++q) { const int cc = 32 * cb + crow(q, hh); const bool keep = dir ? (mm >= cc) : (mm <= cc);
                    *(LAS unsigned short*)(lds + L_ATT + cc * P64 + 2 * mm) = (unsigned short)(cvt_pk_bf16(keep ? acc[q] : 0.f, 0.f) & 0xffffu); }
            }
            GLA_BAR();
            {
                const int cb = w & 1, eb = w >> 1; f32x16 acc = {};
#pragma unroll
                for (int s = 0; s < 4; ++s) acc = GLA_MFMA(frag(lds + L_ATT + (32 * cb + r) * P64 + (16 * s + 8 * hh) * 2), frag(lds + L_VT + SWZ64(32 * eb + r, 2 * s + hh)), acc);
#pragma unroll
                for (int s = 0; s < 8; ++s) acc = GLA_MFMA(frag(lds + L_QI + (32 * cb + r) * P128 + (16 * s + 8 * hh) * 2), frag(lds + L_ST + (32 * eb + r) * P128 + (16 * s + 8 * hh) * 2), acc);
                bf16_t* op = Od + (row0 + 32 * cb) * D + h * 256 + es * 128 + 32 * eb + r;
#pragma unroll
                for (int q = 0; q < 16; ++q) op[(size_t)crow(q, hh) * D] = (bf16_t)(cvt_pk_bf16(acc[q], 0.f) & 0xffffu);
            }
        }
#pragma unroll
        for (int t = 0; t < 2; ++t) {
#pragma unroll
            for (int s = 0; s < 4; ++s) S[t] = GLA_MFMA(frag(lds + L_KST + SWZ64(32 * db + r, 2 * s + hh)), frag(lds + L_VT + SWZ64(32 * (2 * ebp + t) + r, 2 * s + hh)), S[t]);
#pragma unroll
            for (int q = 0; q < 16; ++q) S[t][q] *= *(const LAS float*)(lds + L_DEC + (32 * db + crow(q, hh)) * 4);
        }
        GLA_BAR();
        if (PASS2) {
#pragma unroll
            for (int t = 0; t < 2; ++t)
#pragma unroll
                for (int g4 = 0; g4 < 4; ++g4) { u32x2 pk; pk.x = cvt_pk_bf16(S[t][4 * g4], S[t][4 * g4 + 1]); pk.y = cvt_pk_bf16(S[t][4 * g4 + 2], S[t][4 * g4 + 3]);
                    *(LAS u32x2*)(lds + L_ST + (32 * (2 * ebp + t) + r) * P128 + (32 * db + 8 * g4 + 4 * hh) * 2) = pk; }
        }
    }
    if (!PASS2) {
        float* sp = a.seg + ((size_t)unit * 8 + w) * 2048 + lane;
#pragma unroll
        for (int t = 0; t < 2; ++t)
#pragma unroll
            for (int q = 0; q < 16; ++q) sp[(t * 16 + q) * 64] = S[t][q];
        if (c < 8) *(f32x2*)(a.segd + (size_t)unit * 128 + 16 * g + 2 * c) = (f32x2){__builtin_amdgcn_exp2f(sumb0), __builtin_amdgcn_exp2f(sumb1)};
    }
    GLA_BAR();
}
#undef GLA_MFMA
#undef GLA_LOADS
#undef SWZ64
#undef GLA_BAR
}

constexpr int NWAVES = 8;
constexpr size_t MiB = 1u << 20;
constexpr size_t WS_CTL = 0, CTL_ZERO_BYTES = 64 * 1024;
constexpr size_t WS_TOKE = 1 * MiB, WS_TOKG = WS_TOKE + 256 * 1024, WS_TOKP = WS_TOKG + 256 * 1024, WS_TOKD = WS_TOKP + 256 * 1024, WS_CTAB = WS_TOKD + 256 * 1024;
constexpr size_t WS_MS = 3 * MiB, WS_WRF = WS_MS  , WS_C12 = WS_MS + 256 * 1024, WS_SRC = WS_MS + 512 * 1024  ;
constexpr size_t WS_WIN = 5 * MiB;
constexpr size_t WS_WBRA = 22 * MiB, WS_WBRB = 24 * MiB, WS_WOUT = 26 * MiB;
constexpr size_t WS_H0 = 28 * MiB, WS_RG = 60 * MiB, WS_OF = 92 * MiB, WS_OB = 124 * MiB, WS_O1 = 156 * MiB, WS_O2 = 188 * MiB, WS_QD = 220 * MiB, WS_KD = 252 * MiB, WS_VD = 284 * MiB;
constexpr size_t WS_QKG = 320 * MiB, WS_VG = 352 * MiB, WS_BF = 384 * MiB, WS_BB = 416 * MiB, WS_SEG = 448 * MiB, WS_SEGD = 464 * MiB, WS_ROPE = 468 * MiB;
constexpr size_t WS_WGU = 320 * MiB, WS_WD = 448 * MiB;
constexpr size_t WS_SGG = WS_OB, WS_SGD = WS_O2, WS_MIXED = WS_RG;
constexpr size_t WS_XP = 5 * MiB, WS_ACT = 149 * MiB, WS_Y = 5 * MiB;
constexpr size_t WS_NEED = 512 * MiB;
constexpr int MAXTILES = 288;
constexpr int CW_BAR = 1024;
constexpr int CW_GLAD = 12288;
constexpr int CW_M12 = 14144;
constexpr int CW_GCNT = 14336;
constexpr int CW_TCNT = 8192, CW_XMASK = 12320, CW_T8 = 12352, CW_T9 = 12864, CW_G1 = 13376, CW_T5 = 13632;
constexpr int RING_BYTES = 131072, LDSCTL_OFF = RING_BYTES, LDS_BYTES = 147456;
constexpr int LC_BAR = 0, LC_LCNT = 128, LC_LBASE = 256, LC_OFF = 384, LC_NT = 640, LC_TILE = 1024, LC_MY = 4096, LC_SIMD = 64, LC_MS = 8192;

#define LDS_WAIT() asm volatile("s_waitcnt lgkmcnt(0)" ::: "memory")
#define VM_WAIT() asm volatile("s_waitcnt vmcnt(0)" ::: "memory")
__device__ __forceinline__ unsigned pk2(float lo, float hi) { return cvt_pk_bf16(lo, hi); }
__device__ __forceinline__ float wave_sum(float v) {
#pragma unroll
    for (int o = 1; o < 64; o <<= 1) v += __shfl_xor(v, o);
    return v;
}
__device__ __forceinline__ float half_sum(float v) {
#pragma unroll
    for (int o = 1; o < 32; o <<= 1) v += __shfl_xor(v, o);
    return v;
}

struct Params {
    const float* x; const float* ln0_g; const float* ln0_b; const float* w_in; const float* wf_f; const float* bf_f; const float* wf_b; const float* bf_b;
    const float* gla_g; const float* lq1; const float* lk1; const float* lq2; const float* lk2; const float* diff_g;
    const float* w_bra; const float* w_brb; const float* w_out; const float* ln1_g; const float* ln1_b; const float* router_w; const float* router_b;
    const float* w_gate; const float* b_gate; const float* w_up; const float* b_up; const float* w_down; const float* b_down; const float* ln2_g; const float* ln2_b;
    float* out; unsigned char* ws; int ph_lo, ph_hi;
};

__device__ __forceinline__ void tr_item(const float* W, int pitch, int K, bf16_t* WT, LAS float* scr, int kb, int nb, int lane) {
    const int k0 = 64 * kb, n0 = 32 * nb;
#pragma unroll
    for (int i = 0; i < 8; ++i) { const int kk = 8 * i + (lane >> 3), c4 = (lane & 7) * 4; const f32x4 v = *(const f32x4*)(W + (size_t)(k0 + kk) * pitch + n0 + c4);
        scr[kk * 33 + c4] = v[0]; scr[kk * 33 + c4 + 1] = v[1]; scr[kk * 33 + c4 + 2] = v[2]; scr[kk * 33 + c4 + 3] = v[3]; }
    LDS_WAIT(); asm volatile("" ::: "memory");
    const int c = lane & 7;
#pragma unroll
    for (int j = 0; j < 4; ++j) { const int n = (lane >> 3) + 8 * j; const LAS float* s = scr + (8 * c) * 33 + n;
        u32x4 o; o.x = pk2(s[0 * 33], s[1 * 33]); o.y = pk2(s[2 * 33], s[3 * 33]); o.z = pk2(s[4 * 33], s[5 * 33]); o.w = pk2(s[6 * 33], s[7 * 33]);
        *(u32x4*)(WT + (size_t)(n0 + n) * K + k0 + 8 * c) = o; }
    LDS_WAIT(); asm volatile("" ::: "memory");
}
__device__ __forceinline__ void ln_row(const float* xrow, const float* g, const float* b, int lane, f32x4 (&v)[4]) {
    float s = 0.f;
#pragma unroll
    for (int j = 0; j < 4; ++j) { v[j] = *(const f32x4*)(xrow + 256 * j + 4 * lane); s += (v[j][0] + v[j][1]) + (v[j][2] + v[j][3]); }
    const float mean = wave_sum(s) * (1.f / D); float s2 = 0.f;
#pragma unroll
    for (int j = 0; j < 4; ++j) { v[j] = v[j] - mean; s2 += (v[j][0] * v[j][0] + v[j][1] * v[j][1]) + (v[j][2] * v[j][2] + v[j][3] * v[j][3]); }
    const float rstd = 1.f / sqrtf(wave_sum(s2) * (1.f / D) + LN_EPS);
#pragma unroll
    for (int j = 0; j < 4; ++j) { const f32x4 gg = *(const f32x4*)(g + 256 * j + 4 * lane), bb = *(const f32x4*)(b + 256 * j + 4 * lane); v[j] = v[j] * rstd * gg + bb; }
}
__device__ __forceinline__ void store_row_bf16(bf16_t* orow, int lane, const f32x4 (&v)[4]) {
#pragma unroll
    for (int j = 0; j < 4; ++j) { u32x2 o; o.x = pk2(v[j][0], v[j][1]); o.y = pk2(v[j][2], v[j][3]); *(u32x2*)(orow + 256 * j + 4 * lane) = o; }
}

__global__ void __launch_bounds__(NWAVES * 64, 2) mk_fwd(Params p) {
    extern __shared__ __attribute__((aligned(16))) unsigned char lds_raw[];
    LAS unsigned char* lds = (LAS unsigned char*)lds_raw;
    LAS unsigned char* lctl = lds + LDSCTL_OFF;
    const int tid = threadIdx.x, lane = tid & 63, wave = __builtin_amdgcn_readfirstlane(tid >> 6);
    const int G = gridDim.x; const int bx = blockIdx.x; const int vcu = (G % 8 == 0) ? (bx % 8) * (G / 8) + bx / 8 : bx;
    const int gw = vcu * NWAVES + wave, NGW = G * NWAVES;
    unsigned char* ws = p.ws;
    unsigned* ctl = (unsigned*)(ws + WS_CTL);
    for (int u = tid; u < (LDS_BYTES - LDSCTL_OFF) / 4; u += NWAVES * 64) ((LAS unsigned*)lctl)[u] = 0u;
    __syncthreads();
    int att_half;
    att_half = wave >> 2;
    XcdBarrier bar = xcd_barrier_post(ctl + CW_BAR, (volatile LAS unsigned*)(lctl + LC_BAR));
    if (tid == 0) __hip_atomic_fetch_or(ctl + CW_XMASK + (vcu >> 5), 1u << bar.x, __ATOMIC_RELAXED, __HIP_MEMORY_SCOPE_AGENT);
    const int lo = p.ph_lo, hi = p.ph_hi;
#define IN(k) (lo <= (k) && (k) < hi)
#define SEAM(k) do { if (IN(k) && IN((k) + 1)) xcd_barrier(bar); } while (0)

    bf16_t* Wt_in = (bf16_t*)(ws + WS_WIN); bf16_t* Wbra_t = (bf16_t*)(ws + WS_WBRA); bf16_t* Wbrb_t = (bf16_t*)(ws + WS_WBRB); bf16_t* Wout_t = (bf16_t*)(ws + WS_WOUT);
    float* rope = (float*)(ws + WS_ROPE);
    bf16_t* H0 = (bf16_t*)(ws + WS_H0); bf16_t* RG = (bf16_t*)(ws + WS_RG); bf16_t* OF = (bf16_t*)(ws + WS_OF); bf16_t* OB = (bf16_t*)(ws + WS_OB);
    bf16_t* O1 = (bf16_t*)(ws + WS_O1); bf16_t* O2 = (bf16_t*)(ws + WS_O2); float* BBc = (float*)(ws + WS_BB); float* BFc = (float*)(ws + WS_BF);
    bf16_t* QKG = (bf16_t*)(ws + WS_QKG); bf16_t* VG = (bf16_t*)(ws + WS_VG); bf16_t* QD = (bf16_t*)(ws + WS_QD); bf16_t* KD = (bf16_t*)(ws + WS_KD); bf16_t* VD = (bf16_t*)(ws + WS_VD);
    bf16_t* Wgu_t = (bf16_t*)(ws + WS_WGU); bf16_t* Wd_t = (bf16_t*)(ws + WS_WD);
    bf16_t* SGG = (bf16_t*)(ws + WS_SGG); bf16_t* SGD = (bf16_t*)(ws + WS_SGD); bf16_t* MIXED = (bf16_t*)(ws + WS_MIXED);
    bf16_t* XP = (bf16_t*)(ws + WS_XP); bf16_t* ACT = (bf16_t*)(ws + WS_ACT); bf16_t* YB = (bf16_t*)(ws + WS_Y);
    int* TOKE = (int*)(ws + WS_TOKE); float* TOKG = (float*)(ws + WS_TOKG); int* TOKP = (int*)(ws + WS_TOKP);

#ifndef XR_P0
#define XR_P0 1
#endif
    if (IN(0)) for (int rep0 = 0; rep0 < XR_P0; ++rep0) {
        for (int i = bx * 512 + tid; i < 4096; i += G * 512) { const int j = i & 31, k0 = (i >> 5) * 8; u32x4 h4, l4;
#pragma unroll
            for (int q2 = 0; q2 < 4; ++q2) { const int k = k0 + 2 * q2; const float w0 = p.ln1_g[k] * p.router_w[k * 32 + j], w1 = p.ln1_g[k + 1] * p.router_w[(k + 1) * 32 + j];
                const unsigned h = cvt_pk_bf16(w0, w1); h4[q2] = h; l4[q2] = cvt_pk_bf16(w0 - bflo(h), w1 - bfhi(h)); }
            ((u32x4*)(ws + WS_WRF))[i] = h4; ((u32x4*)(ws + WS_WRF))[4096 + i] = l4; }
        LAS float* scr = (LAS float*)(lds + wave * 8448);
        constexpr int I1 = 16 * 96, I2 = 16 * 96, I3 = 16 * 1, I4 = 16 * 64, IB = 16 * 32;
        constexpr int NIT = I1 + I2 + I3 + I4 + 3 * IB;
        for (int it = gw; it < NIT; it += NGW) {
            int r = it;
            if (r < I1) { tr_item(p.w_in, NIN, D, Wt_in, scr, r / 96, r % 96, lane); continue; } r -= I1;
            if (r < I2) { tr_item(p.w_in + 3104, NIN, D, Wt_in + (size_t)3072 * D, scr, r / 96, r % 96, lane); continue; } r -= I2;
            if (r < I3) { tr_item(p.w_in + 3072, NIN, D, Wt_in + (size_t)6144 * D, scr, r, 0, lane); continue; } r -= I3;
            if (r < I4) { tr_item(p.w_in + 6176, NIN, D, Wt_in + (size_t)6176 * D, scr, r / 64, r % 64, lane); continue; } r -= I4;
            if (r < IB) { tr_item(p.w_bra, D, D, Wbra_t, scr, r / 32, r % 32, lane); continue; } r -= IB;
            if (r < IB) { tr_item(p.w_brb, D, D, Wbrb_t, scr, r / 32, r % 32, lane); continue; } r -= IB;
            tr_item(p.w_out, D, D, Wout_t, scr, r / 32, r % 32, lane);
        }
        for (int m = gw; m < M; m += 4 * NGW) {
            f32x4 v[4][4];
#pragma unroll
            for (int r2 = 0; r2 < 4; ++r2) { const int mm = m + r2 * NGW < M ? m + r2 * NGW : m;
#pragma unroll
                for (int j = 0; j < 4; ++j) v[r2][j] = *(const f32x4*)(p.x + (size_t)mm * D + 256 * j + 4 * lane); }
#pragma unroll
            for (int r2 = 0; r2 < 4; ++r2) { const int mm = m + r2 * NGW; if (mm >= M) break;
                float s = 0.f;
#pragma unroll
                for (int j = 0; j < 4; ++j) s += (v[r2][j][0] + v[r2][j][1]) + (v[r2][j][2] + v[r2][j][3]);
                const float mean = wave_sum(s) * (1.f / D); float s2 = 0.f;
#pragma unroll
                for (int j = 0; j < 4; ++j) { v[r2][j] = v[r2][j] - mean; s2 += (v[r2][j][0] * v[r2][j][0] + v[r2][j][1] * v[r2][j][1]) + (v[r2][j][2] * v[r2][j][2] + v[r2][j][3] * v[r2][j][3]); }
                const float rstd = 1.f / sqrtf(wave_sum(s2) * (1.f / D) + LN_EPS);
#pragma unroll
                for (int j = 0; j < 4; ++j) { const f32x4 gg = *(const f32x4*)(p.ln0_g + 256 * j + 4 * lane), bb = *(const f32x4*)(p.ln0_b + 256 * j + 4 * lane); v[r2][j] = v[r2][j] * rstd * gg + bb; }
                store_row_bf16(H0 + (size_t)mm * D, lane, v[r2]); }
        }
        for (int i = bx * 512 + tid; i < SEQ * 8; i += G * 512) {
            const int pos = i >> 3, f = i & 7;
            const double invf = f == 0 ? 1.0 : f == 1 ? 0.19392274474868576 : f == 2 ? 0.03760603093086393 : f == 3 ? 0.007292664737217109 : f == 4 ? 0.001414213562373095 : f == 5 ? 0.0002742481756762073 : f == 6 ? 5.318295896944988e-05 : 1.031338537721246e-05;
            const double t = (double)pos * invf * 0.15915494309189535; const float fr = (float)(t - floor(t));
            rope[i] = __builtin_amdgcn_cosf(fr); rope[SEQ * 8 + i] = __builtin_amdgcn_sinf(fr);
        }
    }
    SEAM(0);
    bool xcd_ok = false;
    if (lo == 0 && hi >= 15 && G == 256) { bool ok = true;
#pragma unroll
        for (int g8 = 0; g8 < 8; ++g8) { const unsigned mk = __hip_atomic_load(ctl + CW_XMASK + g8, __ATOMIC_RELAXED, __HIP_MEMORY_SCOPE_AGENT); ok = ok && (mk != 0u) && ((mk & (mk - 1u)) == 0u); }
        xcd_ok = ok; }
#define XCD_POST(word) do { VM_WAIT(); __syncthreads(); if (tid == 0) __hip_atomic_fetch_add(ctl + (word), 1u, __ATOMIC_RELAXED, __HIP_MEMORY_SCOPE_AGENT); } while (0)
#define XCD_WAIT(word, n) do { if (tid == 0) { unsigned _sp = 0; while (__hip_atomic_load(ctl + (word), __ATOMIC_RELAXED, __HIP_MEMORY_SCOPE_AGENT) < (unsigned)(n)) { __builtin_amdgcn_s_sleep(2); if (++_sp > (1u << 22)) { atomicAdd(ctl + CW_BAR + XB_TMO, 1u); break; } } __builtin_amdgcn_fence(__ATOMIC_ACQUIRE, "agent"); asm volatile("s_waitcnt vmcnt(0)" ::: "memory"); } __syncthreads(); } while (0)
    if (IN(1)) {
        pg8::Gemm g{H0, Wt_in, M, 6144, D};
        pg8::EpiIn E{QKG, VG, RG, QD, KD, VD, rope};
        pg8::InProjOrder S; S.S0.init(M, 6144, G, bx); S.c = vcu; S.fast = (G == 256);
        pg8::gemm_phase<pg8::EpiIn, pg8::InProjOrder, true, true>(lds, g, S, E);
    }
    if (IN(2)) {
#ifndef XR_G0
#define XR_G0 1
#endif
        for (int rep = 0; rep < XR_G0; ++rep) for (int ch = vcu; ch < M / 64; ch += G) gla::g0_chunk(lds, ch, H0, Wt_in + (size_t)6144 * D, p.wf_f, p.bf_f, p.wf_b, p.bf_b, BFc, BBc);
    }
    SEAM(2);
    const gla::Args ga{QKG, VG, BFc, BBc, (float*)(ws + WS_SEG), (float*)(ws + WS_SEGD), OF, OB};
#ifndef XR_GLA1
#define XR_GLA1 1
#endif
    if (IN(3)) { for (int u = vcu; u < 256; u += G) gla::gla_unit<false>(lds, ga, u);
        if (vcu == 7 % G) {
            LAS float* red = (LAS float*)(lds + 98304);
            const int e = tid & 31, part = tid >> 5; float s1 = 0.f, s2 = 0.f;
            for (int k0 = part * 64; k0 < part * 64 + 64; k0 += 16) { float w[16], g1v[16], b1v[16];
#pragma unroll
                for (int i = 0; i < 16; ++i) { w[i] = p.router_w[(k0 + i) * 32 + e]; g1v[i] = p.ln1_g[k0 + i]; b1v[i] = p.ln1_b[k0 + i]; }
#pragma unroll
                for (int i = 0; i < 16; ++i) { s1 += g1v[i] * w[i]; s2 += b1v[i] * w[i]; } }
            red[part * 32 + e] = s1; red[512 + part * 32 + e] = s2;
            LDS_WAIT(); __syncthreads();
            if (tid < 64) { const int ee = tid & 31, wh = tid >> 5; float s = 0.f;
#pragma unroll
                for (int q = 0; q < 16; ++q) s += red[wh * 512 + q * 32 + ee];
                ((float*)(ws + WS_C12))[tid] = wh ? s + p.router_b[ee] : s; }
            __syncthreads();
        }
        if (xcd_ok) XCD_POST(CW_G1 + 8 * (vcu >> 3)); }
    if (!xcd_ok) SEAM(3);
    if (IN(4)) {
#ifndef XR_GLA2
#define XR_GLA2 1
#endif
        if (xcd_ok) XCD_WAIT(CW_G1 + 8 * (vcu >> 3), 8);
        for (int u = vcu; u < 256; u += G) gla::gla_unit<true>(lds, ga, u);
        __syncthreads();
        if (tid == 0) { __threadfence(); __hip_atomic_fetch_add(ctl + CW_GLAD, 1u, __ATOMIC_RELEASE, __HIP_MEMORY_SCOPE_AGENT); }
        att::CvCfg cg{p.w_gate, p.w_up, p.w_down, Wgu_t, Wd_t, NGW};
        att::CvState cv; cv.R = (f32x4){0.f, 0.f, 0.f, 0.f}; cv.t = 0; cv.rem = 0; cv.it = 0; cv.src = p.w_down; cv.dst = Wd_t;
        LAS float* cscr = (LAS float*)(lds + 53248 + wave * att::CV_SCR_BYTES);
        const bool bg = (G == 256);
        float lam;
        { const float a1 = wave_sum(p.lq1[lane] * p.lk1[lane]), a2 = wave_sum(p.lq2[lane] * p.lk2[lane]); lam = expf(a1) - expf(a2) + LAM_INIT; }
        int round = 0;
        for (int S2 = vcu; S2 < 512; S2 += G) {
            const int bh = S2 >> 5, qb = S2 & 31, b = bh >> 3, h = bh & 7;
            const size_t rb = (size_t)b * SEQ;
            for (int pm = 0; pm < 2; ++pm, ++round) {
                if (bg) {
                    if (round == 1) { if (tid == 0) { { unsigned _sp = 0; while (__hip_atomic_load(ctl + CW_GLAD, __ATOMIC_RELAXED, __HIP_MEMORY_SCOPE_AGENT) < (unsigned)G) { __builtin_amdgcn_s_sleep(8); if (++_sp > (1u << 21)) { atomicAdd(ctl + CW_BAR + XB_TMO, 1u); break; } } } } __syncthreads(); }
                    const int j0 = round == 0 ? 0 : round == 1 ? 5 : round == 2 ? 12 : 18;
                    cv.t = 0; cv.rem = round == 0 ? 5 : round == 1 ? 7 : 6; cv.it = gw + NGW * j0; att::cv_setup(cv, cg);
                }
                att::attn_dense_body(QD + (rb + qb * 256) * D + h * 128 + pm * 64, KD + rb * D + h * 128 + pm * 64, VD + (size_t)((b * 8 + h) * 128) * SEQ, O1 + (rb + qb * 256) * D + h * 128, SEQ, (char*)lds_raw, att_half, cv, cg, cscr, pm, lam, p.diff_g);
            }
        }
        if (!bg) {
            if (tid == 0) { { unsigned _sp = 0; while (__hip_atomic_load(ctl + CW_GLAD, __ATOMIC_RELAXED, __HIP_MEMORY_SCOPE_AGENT) < (unsigned)G) { __builtin_amdgcn_s_sleep(8); if (++_sp > (1u << 21)) { atomicAdd(ctl + CW_BAR + XB_TMO, 1u); break; } } } } __syncthreads();
            LAS float* scr = (LAS float*)(lds + wave * 8448);
            for (int it = gw; it < NE * 3 * 512; it += NGW) {
                const int e = it / 1536, r = it % 1536, mat = r / 512, q = r % 512, kb = q / 32, nb = q % 32, n0 = 32 * nb;
                if (mat == 0) tr_item(p.w_gate + (size_t)e * D * DFF, DFF, D, Wgu_t + ((size_t)e * 2048 + (n0 >> 7) * 256 + (n0 & 127) - n0) * D, scr, kb, nb, lane);
                else if (mat == 1) tr_item(p.w_up + (size_t)e * D * DFF, DFF, D, Wgu_t + ((size_t)e * 2048 + (n0 >> 7) * 256 + 128 + (n0 & 127) - n0) * D, scr, kb, nb, lane);
                else tr_item(p.w_down + (size_t)e * DFF * D, D, DFF, Wd_t + (size_t)e * 1024 * DFF, scr, kb, nb, lane);
            }
        }
    }
    SEAM(4);
    if (IN(5)) {
        const f32x4 gg = *(const f32x4*)(p.gla_g + 4 * lane);
        const int nrow = xcd_ok ? 8 : (M + NGW - 1 - gw) / NGW;
        for (int i5 = 0; i5 < nrow; i5 += 2) {
            const bool two = i5 + 1 < nrow;
            const int m0 = xcd_ok ? (vcu >> 5) * 2048 + (vcu & 31) * 64 + wave * 8 + i5 : gw + i5 * NGW, m1 = two ? (xcd_ok ? m0 + 1 : m0 + NGW) : m0;
            u32x2 av[2][4], bv[2][4], rv[2][4];
#pragma unroll
            for (int r2 = 0; r2 < 2; ++r2) { const size_t ro = (size_t)(r2 ? m1 : m0) * D + 4 * lane;
#pragma unroll
                for (int j = 0; j < 4; ++j) { av[r2][j] = *(const u32x2*)(OF + ro + 256 * j); bv[r2][j] = *(const u32x2*)(OB + ro + 256 * j); rv[r2][j] = *(const u32x2*)(RG + ro + 256 * j); } }
#pragma unroll
            for (int r2 = 0; r2 < 2; ++r2) { if (r2 == 1 && !two) break; const size_t ro = (size_t)(r2 ? m1 : m0) * D + 4 * lane;
#pragma unroll
                for (int j = 0; j < 4; ++j) { const u32x2 a = av[r2][j], b = bv[r2][j], rg = rv[r2][j];
                    f32x4 xv; xv[0] = bflo(a.x) + bflo(b.x); xv[1] = bfhi(a.x) + bfhi(b.x); xv[2] = bflo(a.y) + bflo(b.y); xv[3] = bfhi(a.y) + bfhi(b.y);
                    const float ss = wave_sum((xv[0] * xv[0] + xv[1] * xv[1]) + (xv[2] * xv[2] + xv[3] * xv[3]));
                    const float rs = 1.f / sqrtf(ss * (1.f / 256.f) + LN_EPS);
                    u32x2 o; o.x = pk2(xv[0] * rs * gg[0] * bflo(rg.x), xv[1] * rs * gg[1] * bfhi(rg.x)); o.y = pk2(xv[2] * rs * gg[2] * bflo(rg.y), xv[3] * rs * gg[3] * bfhi(rg.y));
                    *(u32x2*)(OF + ro + 256 * j) = o; } }
        }
        if (xcd_ok) XCD_POST(CW_T5 + 8 * ((vcu >> 5) * 8 + ((vcu & 31) >> 2)));
    }
    if (!xcd_ok) SEAM(5);
    if (IN(6)) {
        pg8::Gemm g{H0, Wt_in + (size_t)6176 * D, M, D, D};
        pg8::ChainOrder S; S.S0.init(M, D, G, bx); S.ws = ws;
        S.a_h0 = (long)WS_H0; S.a_of = (long)WS_OF; S.a_o1 = (long)WS_O1; S.b_gate = (long)(WS_WIN + (size_t)6176 * D * 2); S.b_bra = (long)WS_WBRA; S.b_brb = (long)WS_WBRB;
        pg8::EpiChain E{SGG, SGD, p.out, MIXED};
        if (xcd_ok) { pg8::Unit u0; S.S0.next(0, u0); XCD_WAIT(CW_T5 + 8 * u0.pm, 4); }
        pg8::gemm_phase<pg8::EpiChain, pg8::ChainOrder, true, true>(lds, g, S, E);
        if (xcd_ok) { pg8::Unit u0; S.S0.next(0, u0); XCD_POST(CW_T8 + 8 * u0.pm); }
    }
    if (!xcd_ok) SEAM(8);
    if (IN(9)) {
        pg8::Gemm g{MIXED, Wout_t, M, D, D}; pg8::StaticOrder S; S.init(M, D, G, bx);
        pg8::EpiResid E{H0, p.out};
        pg8::Unit u0; S.next(0, u0);
        if (xcd_ok) XCD_WAIT(CW_T8 + 8 * u0.pm, 4);
        pg8::gemm_phase<pg8::EpiResid, pg8::StaticOrder, true, true>(lds, g, S, E);
        if (xcd_ok) XCD_POST(CW_T9 + 8 * u0.pm);
    }
    if (!xcd_ok) SEAM(9);
    if (IN(10)) {
        LAS unsigned* lcnt = (LAS unsigned*)(lctl + LC_LCNT);
        LAS int* lbase10 = (LAS int*)(lctl + LC_LBASE); unsigned short* LIST = (unsigned short*)(ws + WS_SRC);
        LAS float* msl = (LAS float*)(lctl + LC_MS);
        const float* C12 = (const float*)(ws + WS_C12);
        for (int blk = vcu; blk < M / 64; blk += G) {
            if (xcd_ok) XCD_WAIT(CW_T9 + 8 * (blk >> 2), 4);
            if (tid < 32) lcnt[tid] = 0u;
            for (int rr = 0; rr < 8; rr += 4) {
                f32x4 v[4][4];
#pragma unroll
                for (int r2 = 0; r2 < 4; ++r2) { const float* xrow = p.out + (size_t)(blk * 64 + wave * 8 + rr + r2) * D;
#pragma unroll
                    for (int j = 0; j < 4; ++j) v[r2][j] = *(const f32x4*)(xrow + 256 * j + 4 * lane); }
#pragma unroll
                for (int r2 = 0; r2 < 4; ++r2) { const int lr = wave * 8 + rr + r2, m = blk * 64 + lr;
                    float s = 0.f;
#pragma unroll
                    for (int j = 0; j < 4; ++j) s += (v[r2][j][0] + v[r2][j][1]) + (v[r2][j][2] + v[r2][j][3]);
                    const float mean = wave_sum(s) * (1.f / D); float s2 = 0.f;
#pragma unroll
                    for (int j = 0; j < 4; ++j) { v[r2][j] = v[r2][j] - mean; s2 += (v[r2][j][0] * v[r2][j][0] + v[r2][j][1] * v[r2][j][1]) + (v[r2][j][2] * v[r2][j][2] + v[r2][j][3] * v[r2][j][3]); }
                    const float rstd = 1.f / sqrtf(wave_sum(s2) * (1.f / D) + LN_EPS);
                    if (lane == 0) { msl[lr * 2] = mean; msl[lr * 2 + 1] = rstd; }
#pragma unroll
                    for (int j = 0; j < 4; ++j) { const f32x4 gg = *(const f32x4*)(p.ln1_g + 256 * j + 4 * lane), bb = *(const f32x4*)(p.ln1_b + 256 * j + 4 * lane); v[r2][j] = v[r2][j] * rstd * gg + bb; }
                    store_row_bf16((bf16_t*)(ws + pg8::h1b_off(m)), lane, v[r2]); }
            }
            f32x16 acc = {};
            { const int rb = wave & 1, kq = wave >> 1, i = lane & 31, kh = lane >> 5;
              const float* ap = p.out + (size_t)(blk * 64 + 32 * rb + i) * D + 256 * kq + 8 * kh;
              const u32x4* bhp = (const u32x4*)(ws + WS_WRF) + (16 * kq) * 64 + lane; const u32x4* blp = bhp + 4096;
#pragma unroll 8
              for (int t = 0; t < 16; ++t) { const f32x4 a0 = *(const f32x4*)(ap + 16 * t), a1 = *(const f32x4*)(ap + 16 * t + 4);
                  const bf16x8 bh = __builtin_bit_cast(bf16x8, bhp[t * 64]), bl = __builtin_bit_cast(bf16x8, blp[t * 64]);
                  u32x4 ah, al;
                  ah[0] = cvt_pk_bf16(a0[0], a0[1]); ah[1] = cvt_pk_bf16(a0[2], a0[3]); ah[2] = cvt_pk_bf16(a1[0], a1[1]); ah[3] = cvt_pk_bf16(a1[2], a1[3]);
                  al[0] = cvt_pk_bf16(a0[0] - bflo(ah[0]), a0[1] - bfhi(ah[0])); al[1] = cvt_pk_bf16(a0[2] - bflo(ah[1]), a0[3] - bfhi(ah[1]));
                  al[2] = cvt_pk_bf16(a1[0] - bflo(ah[2]), a1[1] - bfhi(ah[2])); al[3] = cvt_pk_bf16(a1[2] - bflo(ah[3]), a1[3] - bfhi(ah[3]));
                  const bf16x8 ahv = __builtin_bit_cast(bf16x8, ah), alv = __builtin_bit_cast(bf16x8, al);
                  acc = __builtin_amdgcn_mfma_f32_32x32x16_bf16(ahv, bh, acc, 0, 0, 0); acc = __builtin_amdgcn_mfma_f32_32x32x16_bf16(ahv, bl, acc, 0, 0, 0);
                  acc = __builtin_amdgcn_mfma_f32_32x32x16_bf16(alv, bh, acc, 0, 0, 0); } }
            LAS float* PS = (LAS float*)lds;
            LAS float* LG = (LAS float*)(lds + 32768);
            { const int rb = wave & 1, kq = wave >> 1, j = lane & 31, hh = lane >> 5;
#pragma unroll
              for (int q = 0; q < 16; ++q) PS[(kq * 64 + 32 * rb + ((q & 3) + 8 * (q >> 2) + 4 * hh)) * 32 + j] = acc[q]; }
            LDS_WAIT(); __syncthreads();
            { const int e = tid & 31; const float c1 = C12[e], c2 = C12[32 + e];
#pragma unroll
              for (int q = 0; q < 4; ++q) { const int idx = tid + 512 * q, row = idx >> 5; const float raw = (PS[idx] + PS[2048 + idx]) + (PS[4096 + idx] + PS[6144 + idx]);
                  LG[row * 33 + e] = msl[row * 2 + 1] * (raw - msl[row * 2] * c1) + c2; } }
            LDS_WAIT(); __syncthreads();
            int ti[4], pos[4];
            if (wave == 0) {
                const int m = blk * 64 + lane; float lg[32];
#pragma unroll
                for (int e = 0; e < 32; ++e) lg[e] = LG[lane * 33 + e];
                float tv[4];
#pragma unroll
                for (int k = 0; k < 4; ++k) { float bv = -INFINITY; int bi = 0;
#pragma unroll
                    for (int e = 0; e < 32; ++e) { const bool used = (k > 0 && ti[0] == e) || (k > 1 && ti[1] == e) || (k > 2 && ti[2] == e); const bool take = !used && (lg[e] > bv); bv = take ? lg[e] : bv; bi = take ? e : bi; }
                    tv[k] = bv; ti[k] = bi; }
                const float e1 = __expf(tv[1] - tv[0]), e2 = __expf(tv[2] - tv[0]), e3 = __expf(tv[3] - tv[0]); const float inv = 1.f / (1.f + e1 + e2 + e3);
#pragma unroll
                for (int k = 0; k < 4; ++k) pos[k] = (int)__hip_atomic_fetch_add(lcnt + ti[k], 1u, __ATOMIC_RELAXED, __HIP_MEMORY_SCOPE_WORKGROUP);
                *(u32x4*)(TOKE + m * 4) = (u32x4){(unsigned)ti[0], (unsigned)ti[1], (unsigned)ti[2], (unsigned)ti[3]};
                *(f32x4*)(TOKG + m * 4) = (f32x4){inv, e1 * inv, e2 * inv, e3 * inv};
            }
            LDS_WAIT(); __syncthreads();
            if (tid < 32) lbase10[tid] = (int)__hip_atomic_fetch_add(ctl + CW_GCNT + 64 * tid, lcnt[tid], __ATOMIC_RELAXED, __HIP_MEMORY_SCOPE_AGENT);
            LDS_WAIT(); __syncthreads();
            if (wave == 0) { const int m = blk * 64 + lane;
#pragma unroll
                for (int k = 0; k < 4; ++k) { pos[k] += lbase10[ti[k]]; LIST[ti[k] * M + pos[k]] = (unsigned short)m; }
                *(u32x4*)(TOKP + m * 4) = (u32x4){(unsigned)pos[0], (unsigned)pos[1], (unsigned)pos[2], (unsigned)pos[3]}; }
            __syncthreads();
        }
    }
    SEAM(10);
    LAS int* l_off = (LAS int*)(lctl + LC_OFF); LAS int* l_nt = (LAS int*)(lctl + LC_NT); LAS int* l_tile = (LAS int*)(lctl + LC_TILE);
    LAS int* l_tot = (LAS int*)(lctl + LC_LCNT); LAS int* l_base = (LAS int*)(lctl + LC_LBASE);
    if (lo <= 13 && hi > 11) {
        if (tid < 32) { const int tot = (int)__hip_atomic_load(ctl + CW_GCNT + 64 * tid, __ATOMIC_RELAXED, __HIP_MEMORY_SCOPE_AGENT);
            l_tot[tid] = tot;
            const int t = (tot + 255) >> 8; int inc = t;
#pragma unroll
            for (int d = 1; d < 32; d <<= 1) { const int o = __shfl_up(inc, d, 32); inc += (tid >= d) ? o : 0; }
            const int excl = inc - t; l_off[tid] = excl * 256;
            for (int i = 0; i < t; ++i) l_tile[excl + i] = tid;
            if (tid == 31) { l_off[NE] = inc * 256; l_nt[0] = inc; } }
        LDS_WAIT(); __syncthreads();
    }
    const unsigned short* SRCT = (const unsigned short*)(ws + WS_SRC);
    int f13 = 0; bool mixloc = false; int mixl12 = -1;
    { const int ntl = l_nt[0]; const long n12 = 8L * ntl, full12 = (n12 / G) * G; const int l12 = (int)(n12 - full12);
      mixloc = xcd_ok && lo <= 12 && hi > 13 && l12 > 0 && full12 >= 2L * G && ntl >= 64;
      if (lo <= 12 && hi > 13 && l12 > 0) { long f = G - l12; if (!mixloc) { if (f > 4L * ntl) f = 4L * ntl; if ((f + 3) / 4 > full12 / 8) f = 0; } f13 = (int)f; }
      if (mixloc) mixl12 = l12;
      if (IN(12)) {
        pg8::Gemm g{(const bf16_t*)ws, Wgu_t, MAXTILES * 256, 2048, D};
        { pg8::MoeGatherOrder S{ntl, 8, G, vcu, l_tile, SRCT, (lo <= 12 && hi > 13) ? full12 : n12, l_off, l_tot, mixloc ? ctl + CW_M12 + 16 * (vcu >> 5) : nullptr};
          pg8::EpiSwiglu E{p.b_gate, p.b_up, ACT};
          pg8::gemm_phase<pg8::EpiSwiglu, pg8::MoeGatherOrder, true, true>(lds, g, S, E); }
        if (lo <= 12 && hi > 13 && l12 > 0) {
            if (mixloc) { if (vcu >= l12) XCD_WAIT(CW_M12 + 16 * (vcu >> 5), 32); }
            else xcd_barrier(bar);
            pg8::MoeMixOrder S{vcu, l12, f13, full12, l_tile, SRCT, (unsigned)WS_ACT, ws, (long)WS_WGU, (long)WS_WD, l_off, l_tot, mixloc};
            pg8::EpiMoe E{pg8::EpiSwiglu{p.b_gate, p.b_up, ACT}, pg8::EpiBiasBf16{p.b_down, YB}};
            pg8::gemm_phase<pg8::EpiMoe, pg8::MoeMixOrder, true, true>(lds, g, S, E);
        }
      }
    }
    SEAM(12);
    if (IN(13)) {
        pg8::Gemm g{ACT, Wd_t, MAXTILES * 256, D, DFF}; pg8::MoeOrder S{l_nt[0], 4, G, vcu, l_tile, (long)f13, mixl12};
        pg8::EpiBiasBf16 E{p.b_down, YB};
        pg8::gemm_phase<pg8::EpiBiasBf16, pg8::MoeOrder, true, true>(lds, g, S, E);
    }
    SEAM(13);
    if (IN(14)) {
        const bool bad = __hip_atomic_load(ctl + CW_BAR + XB_TMO, __ATOMIC_RELAXED, __HIP_MEMORY_SCOPE_AGENT) != 0u;
#ifndef XR_P14
#define XR_P14 1
#endif
        for (int rep14 = 0; rep14 < XR_P14; ++rep14) { float* outp = (rep14 + 1 < XR_P14) ? (float*)ACT : p.out;
        f32x4 g2[4], b2[4];
#pragma unroll
        for (int j = 0; j < 4; ++j) { g2[j] = *(const f32x4*)(p.ln2_g + 256 * j + 4 * lane); b2[j] = *(const f32x4*)(p.ln2_b + 256 * j + 4 * lane); }
#define P14_TOK(mb_, G_, D_) do { _Pragma("unroll") for (int r2 = 0; r2 < 2; ++r2) { const int m = (mb_) + r2 * NGW; \
            _Pragma("unroll") for (int k = 0; k < 4; ++k) { G_[r2][k] = TOKG[m * 4 + k]; D_[r2][k] = l_off[TOKE[m * 4 + k]] + TOKP[m * 4 + k]; } } } while (0)
        float gk[2][4]; int dk[2][4];
        if (gw < M) P14_TOK(gw, gk, dk);
        for (int m0 = gw; m0 < M; m0 += 2 * NGW) {
            f32x4 v[2][4]; float s[2];
            u32x2 hb[2][4], yv[2][4][4];
#pragma unroll
            for (int r2 = 0; r2 < 2; ++r2) { const int m = m0 + r2 * NGW;
#pragma unroll
                for (int j = 0; j < 4; ++j) {
                    hb[r2][j] = *(const u32x2*)(ws + pg8::h1b_off(m) + (size_t)(256 * j + 4 * lane) * 2);
#pragma unroll
                    for (int k = 0; k < 4; ++k) yv[r2][j][k] = *(const u32x2*)(YB + (dk[r2][k] >= pg8::Y_SPLIT_TILE * 256 ? pg8::Y_DELTA : (size_t)0) + (size_t)dk[r2][k] * D + 256 * j + 4 * lane); } }
            float gkn[2][4]; int dkn[2][4]; const bool more = m0 + 2 * NGW < M;
            if (more) P14_TOK(m0 + 2 * NGW, gkn, dkn);
#pragma unroll
            for (int r2 = 0; r2 < 2; ++r2) { s[r2] = 0.f;
#pragma unroll
                for (int j = 0; j < 4; ++j) {
                    f32x4 a = (f32x4){bflo(hb[r2][j].x), bfhi(hb[r2][j].x), bflo(hb[r2][j].y), bfhi(hb[r2][j].y)} * DN_ALPHA;
#pragma unroll
                    for (int k = 0; k < 4; ++k) { const u32x2 y = yv[r2][j][k];
                        a[0] += gk[r2][k] * bflo(y.x); a[1] += gk[r2][k] * bfhi(y.x); a[2] += gk[r2][k] * bflo(y.y); a[3] += gk[r2][k] * bfhi(y.y); }
                    v[r2][j] = a; s[r2] += (a[0] + a[1]) + (a[2] + a[3]); } }
            if (more) {
#pragma unroll
                for (int r2 = 0; r2 < 2; ++r2)
#pragma unroll
                    for (int k = 0; k < 4; ++k) { gk[r2][k] = gkn[r2][k]; dk[r2][k] = dkn[r2][k]; } }
#pragma unroll
            for (int r2 = 0; r2 < 2; ++r2) { const int m = m0 + r2 * NGW;
                const float mean = wave_sum(s[r2]) * (1.f / D); float s2 = 0.f;
#pragma unroll
                for (int j = 0; j < 4; ++j) { v[r2][j] = v[r2][j] - mean; s2 += (v[r2][j][0] * v[r2][j][0] + v[r2][j][1] * v[r2][j][1]) + (v[r2][j][2] * v[r2][j][2] + v[r2][j][3] * v[r2][j][3]); }
                const float rstd = 1.f / sqrtf(wave_sum(s2) * (1.f / D) + LN_EPS);
#pragma unroll
                for (int j = 0; j < 4; ++j) { f32x4 o = v[r2][j] * rstd * g2[j] + b2[j];
                    if (bad) { const float q = __builtin_nanf(""); o = (f32x4){q, q, q, q}; }
                    *(f32x4*)(outp + (size_t)m * D + 256 * j + 4 * lane) = o; } }
        } }
    }
#undef IN
#undef SEAM
}

#ifndef MK_NLAUNCH
#define MK_NLAUNCH 1
#endif
constexpr int NPHASE = 15;
extern "C" void kernel_launch(void* const* d_in, const int* in_sizes, int n_in, void* d_out, int out_size, void* d_ws, size_t ws_size, hipStream_t stream) {
    static int grid = 0;
    if (grid == 0) {
        if (n_in != 29 || in_sizes[0] != M * D || out_size != M * D || ws_size < WS_NEED) { fprintf(stderr, "kernel_launch: unexpected shapes (n_in %d, in0 %d, out %d, ws %zu)\n", n_in, n_in > 0 ? in_sizes[0] : -1, out_size, ws_size); grid = -1; return; }
        int dev = 0, cus = 0, per_cu = 0;
        if (hipGetDevice(&dev) != hipSuccess || hipDeviceGetAttribute(&cus, hipDeviceAttributeMultiprocessorCount, dev) != hipSuccess) { grid = -1; return; }
        if (hipFuncSetAttribute((const void*)mk_fwd, hipFuncAttributeMaxDynamicSharedMemorySize, LDS_BYTES) != hipSuccess) { fprintf(stderr, "kernel_launch: hipFuncSetAttribute failed\n"); grid = -1; return; }
        if (hipOccupancyMaxActiveBlocksPerMultiprocessor(&per_cu, (const void*)mk_fwd, NWAVES * 64, LDS_BYTES) != hipSuccess || per_cu < 1) fprintf(stderr, "kernel_launch: occupancy query reports %d\n", per_cu);
        (void)hipGetLastError();
        grid = cus;
    }
    if (grid < 0) return;
    (void)hipMemsetAsync((char*)d_ws + WS_CTL, 0, CTL_ZERO_BYTES, stream);
    Params p{};
    const float** f = (const float**)&p;
    for (int i = 0; i < 29; ++i) f[i] = (const float*)d_in[i];
    p.out = (float*)d_out; p.ws = (unsigned char*)d_ws;
#if MK_NLAUNCH == 1
    p.ph_lo = 0; p.ph_hi = NPHASE;
    hipLaunchKernelGGL(mk_fwd, dim3(grid), dim3(NWAVES * 64), LDS_BYTES, stream, p);
#else
    for (int k = 0; k < NPHASE; ++k) { p.ph_lo = k; p.ph_hi = k + 1; hipLaunchKernelGGL(mk_fwd, dim3(grid), dim3(NWAVES * 64), LDS_BYTES, stream, p); }
#endif
}
```
